# Optimizing an MI355X kernel written in HIP

```python
import math
import jax, jax.numpy as jnp
from jax import lax
import numpy as np

D_MODEL = 1024
BATCH = 8
SEQ = 4096
DEPTH = 1

CHUNK = 64
LEFT_CHUNKS = 8
BAND = (LEFT_CHUNKS + 1) * CHUNK
HEAD_DIM = 64
A_HEADS = 8
A_WIDTH = A_HEADS * HEAD_DIM
REL_CLIP = 256
B_HEADS = 4
B_QK_WIDTH = B_HEADS * 2 * HEAD_DIM
B_V_WIDTH = B_HEADS * 2 * HEAD_DIM
ROPE_THETA = 500000.0
ROT_DIM = HEAD_DIM // 4
D_FF = 2816
Q_BLOCK = 128
EPS = 1e-6
NEG = -1e30
IN_SIZES = (A_WIDTH, A_WIDTH, A_WIDTH, B_QK_WIDTH, B_QK_WIDTH, B_V_WIDTH, D_MODEL, D_MODEL)
IN_WIDTH = sum(IN_SIZES)
IN_SPLITS = np.cumsum(IN_SIZES)[:-1].tolist()

kernel_name = 'hybrid_chunk_diff_macaron'


def rms_norm(x, g):
    xf = x.astype(jnp.float32)
    y = xf * lax.rsqrt(jnp.mean(xf * xf, axis=-1, keepdims=True) + EPS)
    return (y * g.astype(jnp.float32)).astype(x.dtype)


def swiglu(x, w_gu, w_down):
    g, u = jnp.split(x @ w_gu, 2, axis=-1)
    return (jax.nn.silu(g) * u) @ w_down


def partial_rotary(x):
    s = x.shape[1]
    pos = jnp.arange(s, dtype=jnp.float32)
    inv = ROPE_THETA ** (-jnp.arange(0, ROT_DIM, 2, dtype=jnp.float32) / ROT_DIM)
    ang = pos[:, None] * inv[None, :]
    cos = jnp.concatenate([jnp.cos(ang)] * 2, axis=-1)[None, :, None, :]
    sin = jnp.concatenate([jnp.sin(ang)] * 2, axis=-1)[None, :, None, :]
    xr = x[..., :ROT_DIM].astype(jnp.float32)
    x1, x2 = xr[..., :ROT_DIM // 2], xr[..., ROT_DIM // 2:]
    rot = jnp.concatenate([-x2, x1], axis=-1)
    xr = (xr * cos + rot * sin).astype(x.dtype)
    return jnp.concatenate([xr, x[..., ROT_DIM:]], axis=-1)


def chunk_band_attention(q, k, v, rel_table):
    b, s, h, d = q.shape
    nc = s // CHUNK
    pad = LEFT_CHUNKS * CHUNK
    kp = jnp.pad(k, ((0, 0), (pad, 0), (0, 0), (0, 0)))
    vp = jnp.pad(v, ((0, 0), (pad, 0), (0, 0), (0, 0)))
    i = jnp.arange(CHUNK)[:, None]
    j = jnp.arange(BAND)[None, :]
    rel = i - j + pad
    idx = jnp.clip(rel, -REL_CLIP, REL_CLIP) + REL_CLIP
    bias = jnp.transpose(rel_table[idx], (2, 0, 1)).astype(jnp.float32)
    scale = 1.0 / math.sqrt(d)

    def one_chunk(c):
        qc = lax.dynamic_slice_in_dim(q, c * CHUNK, CHUNK, axis=1)
        kb = lax.dynamic_slice_in_dim(kp, c * CHUNK, BAND, axis=1)
        vb = lax.dynamic_slice_in_dim(vp, c * CHUNK, BAND, axis=1)
        sc = jnp.einsum('bqhd,bkhd->bhqk', qc, kb).astype(jnp.float32) * scale + bias
        valid = (j >= pad - c * CHUNK)[None, None]
        p = jax.nn.softmax(jnp.where(valid, sc, NEG), axis=-1).astype(v.dtype)
        return jnp.einsum('bhqk,bkhd->bqhd', p, vb)

    out = lax.map(one_chunk, jnp.arange(nc))
    return jnp.transpose(out, (1, 0, 2, 3, 4)).reshape(b, s, h * d)


def diff_attention(q1, q2, k1, k2, v, lam, g_sub, lambda_init):
    b, s, h, d = q1.shape
    nb = s // Q_BLOCK
    kchunk = jnp.arange(s) // CHUNK
    scale = 1.0 / math.sqrt(d)

    def one_block(blk):
        st = blk * Q_BLOCK
        q1b = lax.dynamic_slice_in_dim(q1, st, Q_BLOCK, axis=1)
        q2b = lax.dynamic_slice_in_dim(q2, st, Q_BLOCK, axis=1)
        qchunk = (st + jnp.arange(Q_BLOCK)) // CHUNK
        mask = (kchunk[None, :] <= qchunk[:, None])[None, None]
        s1 = jnp.einsum('bqhd,bkhd->bhqk', q1b, k1).astype(jnp.float32) * scale
        s2 = jnp.einsum('bqhd,bkhd->bhqk', q2b, k2).astype(jnp.float32) * scale
        p1 = jax.nn.softmax(jnp.where(mask, s1, NEG), axis=-1)
        p2 = jax.nn.softmax(jnp.where(mask, s2, NEG), axis=-1)
        a = (p1 - lam * p2).astype(v.dtype)
        o = jnp.einsum('bhqk,bkhe->bqhe', a, v)
        return rms_norm(o, g_sub) * (1.0 - lambda_init)

    out = lax.map(one_block, jnp.arange(nb))
    return jnp.transpose(out, (1, 0, 2, 3, 4)).reshape(b, s, h * 2 * d)


def setup_inputs(seed: int = 0) -> dict:
    key = jax.random.key(seed)
    ks = jax.random.split(key, 24)
    f = jnp.float32

    def w(k, shape, fan_in):
        return jax.random.normal(k, shape, f) * fan_in ** -0.5

    def gain(k, n):
        return 1.0 + 0.01 * jax.random.normal(k, (DEPTH, n), f)

    return {
        'x': jax.random.normal(ks[0], (BATCH, SEQ, D_MODEL), f),
        'g_ffn1': gain(ks[1], D_MODEL),
        'w_ffn1_gu': w(ks[2], (DEPTH, D_MODEL, 2 * D_FF), D_MODEL),
        'w_ffn1_down': w(ks[3], (DEPTH, D_FF, D_MODEL), D_FF),
        'g_mix': gain(ks[4], D_MODEL),
        'w_in': w(ks[5], (DEPTH, D_MODEL, IN_WIDTH), D_MODEL),
        'qn_a': gain(ks[6], HEAD_DIM),
        'kn_a': gain(ks[7], HEAD_DIM),
        'rel_bias': 0.1 * jax.random.normal(ks[8], (DEPTH, 2 * REL_CLIP + 1, A_HEADS), f),
        'qn_b': gain(ks[9], HEAD_DIM),
        'kn_b': gain(ks[10], HEAD_DIM),
        'lambda_q1': 0.1 * jax.random.normal(ks[11], (DEPTH, HEAD_DIM), f),
        'lambda_k1': 0.1 * jax.random.normal(ks[12], (DEPTH, HEAD_DIM), f),
        'lambda_q2': 0.1 * jax.random.normal(ks[13], (DEPTH, HEAD_DIM), f),
        'lambda_k2': 0.1 * jax.random.normal(ks[14], (DEPTH, HEAD_DIM), f),
        'g_subln': gain(ks[15], 2 * HEAD_DIM),
        'w_up_a': w(ks[16], (DEPTH, A_WIDTH, D_MODEL), A_WIDTH),
        'w_up_b': w(ks[17], (DEPTH, B_V_WIDTH, D_MODEL), B_V_WIDTH),
        'w_out': w(ks[18], (DEPTH, D_MODEL, D_MODEL), D_MODEL),
        'g_ffn2': gain(ks[19], D_MODEL),
        'w_ffn2_gu': w(ks[20], (DEPTH, D_MODEL, 2 * D_FF), D_MODEL),
        'w_ffn2_down': w(ks[21], (DEPTH, D_FF, D_MODEL), D_FF),
        'g_final': gain(ks[22], D_MODEL),
    }


def reference(x, g_ffn1, w_ffn1_gu, w_ffn1_down, g_mix, w_in, qn_a, kn_a, rel_bias,
              qn_b, kn_b, lambda_q1, lambda_k1, lambda_q2, lambda_k2, g_subln,
              w_up_a, w_up_b, w_out, g_ffn2, w_ffn2_gu, w_ffn2_down, g_final):
    b, s, _ = x.shape
    for l in range(DEPTH):
        x = x + 0.5 * swiglu(rms_norm(x, g_ffn1[l]), w_ffn1_gu[l], w_ffn1_down[l])

        h = rms_norm(x, g_mix[l])
        qa, ka, va, qb, kb, vb, ga, gb = jnp.split(h @ w_in[l], IN_SPLITS, axis=-1)

        qa = rms_norm(qa.reshape(b, s, A_HEADS, HEAD_DIM), qn_a[l])
        ka = rms_norm(ka.reshape(b, s, A_HEADS, HEAD_DIM), kn_a[l])
        va = va.reshape(b, s, A_HEADS, HEAD_DIM)
        oa = chunk_band_attention(qa, ka, va, rel_bias[l])

        qb = partial_rotary(rms_norm(qb.reshape(b, s, 2 * B_HEADS, HEAD_DIM), qn_b[l]))
        kb = partial_rotary(rms_norm(kb.reshape(b, s, 2 * B_HEADS, HEAD_DIM), kn_b[l]))
        vb = vb.reshape(b, s, B_HEADS, 2 * HEAD_DIM)
        lambda_init = 0.8 - 0.6 * math.exp(-0.3 * l)
        lam = (jnp.exp(jnp.sum(lambda_q1[l].astype(jnp.float32) * lambda_k1[l].astype(jnp.float32)))
               - jnp.exp(jnp.sum(lambda_q2[l].astype(jnp.float32) * lambda_k2[l].astype(jnp.float32)))
               + lambda_init)
        ob = diff_attention(qb[:, :, 0::2], qb[:, :, 1::2], kb[:, :, 0::2], kb[:, :, 1::2],
                            vb, lam, g_subln[l], lambda_init)

        y = jax.nn.sigmoid(ga) * (oa @ w_up_a[l]) + jax.nn.sigmoid(gb) * (ob @ w_up_b[l])
        x = x + y @ w_out[l]

        x = x + 0.5 * swiglu(rms_norm(x, g_ffn2[l]), w_ffn2_gu[l], w_ffn2_down[l])
        x = rms_norm(x, g_final[l])
    return x
```

```cpp
#include <hip/hip_runtime.h>
#include <hip/hip_cooperative_groups.h>
#include <cstdio>
#include <cstdint>
namespace cg = cooperative_groups;

#ifndef MK_N_LAUNCHES
#define MK_N_LAUNCHES 1
#endif
#ifndef PROBE_REP_PHASE
#define PROBE_REP_PHASE -1
#endif

#define LAS __attribute__((address_space(3)))
typedef unsigned short bf16_t;
typedef short bf16x8 __attribute__((ext_vector_type(8)));
typedef short s16x4 __attribute__((ext_vector_type(4)));
typedef float f32x4 __attribute__((ext_vector_type(4)));
typedef float f32x16 __attribute__((ext_vector_type(16)));
typedef unsigned u32x4 __attribute__((ext_vector_type(4)));
typedef unsigned u32x2 __attribute__((ext_vector_type(2)));
typedef float f32x2_t __attribute__((ext_vector_type(2)));
typedef __bf16 bf16x2_t __attribute__((ext_vector_type(2)));

constexpr int M = 32768, DM = 1024, FF = 2816, NIN = 5120, SEQ = 4096;
constexpr float EPS = 1e-6f;
constexpr float LOG2E = 1.4426950408889634f;
constexpr float QSCALE = 0.125f * LOG2E;

__device__ __forceinline__ unsigned cvtpk(float lo, float hi) { f32x2_t v = {lo, hi}; bf16x2_t b = __builtin_convertvector(v, bf16x2_t); return __builtin_bit_cast(unsigned, b); }
__device__ __forceinline__ float bflo(unsigned u) { return __uint_as_float(u << 16); }
__device__ __forceinline__ float bfhi(unsigned u) { return __uint_as_float(u & 0xffff0000u); }
__device__ __forceinline__ float wave_sum(float v) {
#pragma unroll
    for (int o = 1; o < 64; o <<= 1) v += __shfl_xor(v, o);
    return v;
}
__device__ __forceinline__ float sum_x16(float v) { auto rr = __builtin_amdgcn_permlane16_swap(__float_as_uint(v), __float_as_uint(v), false, false); return __uint_as_float(rr[0]) + __uint_as_float(rr[1]); }
__device__ __forceinline__ float sum_x32(float v) { auto rr = __builtin_amdgcn_permlane32_swap(__float_as_uint(v), __float_as_uint(v), false, false); return __uint_as_float(rr[0]) + __uint_as_float(rr[1]); }
__device__ __forceinline__ float get_x16(float v, int oddrow) { auto rr = __builtin_amdgcn_permlane16_swap(__float_as_uint(v), __float_as_uint(v), false, false); return __uint_as_float(oddrow ? rr[0] : rr[1]); }
__device__ __forceinline__ float fast_exp2(float x) { return __builtin_amdgcn_exp2f(x); }
__device__ __forceinline__ float fast_rcp(float x) { return __builtin_amdgcn_rcpf(x); }
__device__ __forceinline__ float sigmoidf_(float x) { return fast_rcp(1.0f + fast_exp2(-x * LOG2E)); }

template <int NP>
__device__ __forceinline__ float row_rs(const float* ss, int row) {
    float v[NP];
#pragma unroll
    for (int p = 0; p < NP; ++p) v[p] = ss[(size_t)p * M + row];
    float s = 0.f;
#pragma unroll
    for (int p = 0; p < NP; ++p) s += v[p];
    return rsqrtf(s * (1.0f / DM) + EPS);
}

constexpr int LDS_RS = 131072;
template <int NP>
__device__ __forceinline__ void rs_prep(LAS unsigned char* lds, const float* ss, int pm, int ui) {
    const int t = threadIdx.x;
    if (t < 256) ((LAS float*)(lds + LDS_RS + (ui & 1) * 1024))[t] = row_rs<NP>(ss, pm * 256 + t);
}
__device__ __forceinline__ float rs_get(LAS unsigned char* lds, int ui, int lrow) { return ((LAS float*)(lds + LDS_RS + (ui & 1) * 1024))[lrow]; }

namespace pg8 {
constexpr int BM = 256, BK = 64, HALF = 128, HTB = HALF * BK * 2, STAGE_BYTES = 8 * HTB, NXCD = 8, WGM = 8;
__host__ __device__ __forceinline__ int lds_byte(int r, int c) { const int st = (r >> 4) * 2 + (c >> 5), rr = r & 15, cc = c & 31, ob = rr * 64 + cc * 2; return st * 1024 + (ob ^ (((ob >> 9) & 1) << 5)); }
__host__ __device__ __forceinline__ void stage_rc(int b, int& R, int& C) { const int st = b / 1024, sb = b % 1024, swz = sb ^ (((sb >> 9) & 1) << 5); R = (st >> 1) * 16 + swz / 64; C = (st & 1) * 32 + (swz % 64) / 2; }
__host__ __device__ __forceinline__ int perm32(int rho) { const int n = rho >> 4, i = rho & 15; return 8 * (i >> 2) + 4 * n + (i & 3); }

struct Unit { int pm, pn, kh; };
struct Gemm { const bf16_t* A; const bf16_t* Bt; int lda, ldb, K, akh, bkh; };

struct StaticOrder {
    int nM, nN, nwg, G, c, KH;
    __device__ void init(int Mr, int N, int G_, int c_, int KH_) { nM = Mr / BM; nN = N / BM; nwg = nM * nN; G = G_; c = c_; KH = KH_; }
    __device__ bool next(int i, Unit& u) const {
        const int it = (KH == 2) ? (i >> 1) : i; u.kh = (KH == 2) ? (i & 1) : 0;
        const long L = (long)it * G + c; if (L >= nwg) return false;
        int wgid = (int)L; { const int q = nwg / NXCD, r = nwg % NXCD, xcd = wgid % NXCD, off = wgid / NXCD; wgid = (xcd < r ? xcd * (q + 1) : r * (q + 1) + (xcd - r) * q) + off; }
        const int nig = WGM * nN, gid = wgid / nig, fm = gid * WGM, gsz = (nM - fm) < WGM ? (nM - fm) : WGM;
        u.pm = fm + ((wgid % nig) % gsz); u.pn = (wgid % nig) / gsz; return true;
    }
};

template <class Epi, class Sched>
__device__ __forceinline__ void gemm_phase(LAS unsigned char* lds, const Gemm g, const Sched& S, const Epi& E) {
    const int tid = threadIdx.x, wid = __builtin_amdgcn_readfirstlane(tid >> 6), lane = tid & 63, wr = wid >> 2, wc = wid & 3, fr = lane & 15, fq = lane >> 4;
    const int nt = g.K / BK;
    unsigned voffA[2], voffB[2];
#pragma unroll
    for (int i = 0; i < 2; ++i) { int R, C; stage_rc(tid * 16 + i * 8192, R, C); const int Rb = (R & ~31) + perm32(R & 31);
        voffA[i] = (unsigned)(R * g.lda + C) * 2u; voffB[i] = (unsigned)(Rb * g.ldb + C) * 2u; }
    const size_t kstep = (size_t)(BK * 2);
    const size_t hstepA = (size_t)HALF * g.lda * 2, hstepB = (size_t)HALF * g.ldb * 2;
    const size_t tstepA = 2 * hstepA, tstepB = 2 * hstepB;
    const unsigned ldsw = (unsigned)wid * 1024u;
    const int aoff = lds_byte(wr * 64 + fr, fq * 8), boff = lds_byte(wc * 32 + fr, fq * 8);
#define PG8_SA(b, h) (((b) * 2 + (h)) * HTB)
#define PG8_SB(b, h) ((4 + (b) * 2 + (h)) * HTB)
#define PG8_STAGE(bufoff, gbase, voff) do { _Pragma("unroll") for (int _i = 0; _i < 2; ++_i) \
        __builtin_amdgcn_global_load_lds((const unsigned*)((const char*)(gbase) + (voff)[_i]), (LAS unsigned*)(lds + (bufoff) + ldsw + _i * 8192), 16, 0, 0); } while (0)
#define PG8_LDA(dst, b, h) do { _Pragma("unroll") for (int m = 0; m < 4; ++m) _Pragma("unroll") for (int k = 0; k < 2; ++k) dst[m][k] = *(const LAS bf16x8*)(lds + PG8_SA(b, h) + aoff + m * 2048 + k * 1024); } while (0)
#define PG8_LDB(dst, b, h) do { _Pragma("unroll") for (int n = 0; n < 2; ++n) _Pragma("unroll") for (int k = 0; k < 2; ++k) dst[n][k] = *(const LAS bf16x8*)(lds + PG8_SB(b, h) + boff + n * 2048 + k * 1024); } while (0)
#define PG8_MMA(ai, bj, At, Bt) do { __builtin_amdgcn_s_setprio(1); _Pragma("unroll") for (int m = 0; m < 4; ++m) _Pragma("unroll") for (int n = 0; n < 2; ++n) _Pragma("unroll") for (int k = 0; k < 2; ++k) \
        acc[ai][bj][m][n] = __builtin_amdgcn_mfma_f32_16x16x32_bf16(Bt[n][k], At[m][k], acc[ai][bj][m][n], 0, 0, 0); __builtin_amdgcn_s_setprio(0); } while (0)
#define PG8_WAIT_V(n) asm volatile("s_waitcnt vmcnt(" #n ")" ::: "memory")
#define PG8_WAIT_L(n) asm volatile("s_waitcnt lgkmcnt(" #n ")" ::: "memory")
#define PG8_BAR __builtin_amdgcn_s_barrier()
#define PG8_SCHED __builtin_amdgcn_sched_barrier(0)
#define PG8_UA(u) ((const char*)g.A + (size_t)(u).pm * tstepA + (size_t)((u).kh * g.akh) * 2)
#define PG8_UB(u) ((const char*)g.Bt + (size_t)(u).pn * tstepB + (size_t)((u).kh * g.bkh) * 2)
    Unit cur, nxt; int ui = 0;
    if (!S.next(0, cur)) return;
    f32x4 acc[2][2][4][2];
#pragma unroll
    for (int a = 0; a < 2; ++a)
#pragma unroll
        for (int b = 0; b < 2; ++b)
#pragma unroll
            for (int m = 0; m < 4; ++m)
#pragma unroll
                for (int n = 0; n < 2; ++n) acc[a][b][m][n] = (f32x4){0.f, 0.f, 0.f, 0.f};
    bf16x8 At[4][2], B0[2][2], B1[2][2];
    const char* cA = PG8_UA(cur); const char* cB = PG8_UB(cur);
    E.prep(lds, cur, 0);
    PG8_STAGE(PG8_SB(0, 0), cB, voffB); PG8_STAGE(PG8_SB(0, 1), cB + hstepB, voffB); PG8_STAGE(PG8_SA(0, 0), cA, voffA); PG8_STAGE(PG8_SA(0, 1), cA + hstepA, voffA);
    if (wr == 1) PG8_BAR;
    PG8_WAIT_V(2); PG8_BAR;
    PG8_STAGE(PG8_SB(1, 0), cB + kstep, voffB); PG8_STAGE(PG8_SA(1, 0), cA + kstep, voffA); PG8_STAGE(PG8_SB(1, 1), cB + hstepB + kstep, voffB);
    PG8_WAIT_V(6); PG8_BAR;
    for (;;) {
        const bool has_next = S.next(ui + 1, nxt);
        const char* nA = has_next ? PG8_UA(nxt) : cA; const char* nB = has_next ? PG8_UB(nxt) : cB;
        for (int t = 0; t < nt; t += 2) {
            const bool last = (t == nt - 2);
            const char* a1 = cA + (size_t)(t + 1) * kstep;
            const char* a2 = last ? nA : cA + (size_t)(t + 2) * kstep; const char* b2 = last ? nB : cB + (size_t)(t + 2) * kstep;
            const char* a3 = a2 + kstep; const char* b3 = b2 + kstep;
            PG8_LDB(B0, 0, 0); PG8_LDB(B1, 0, 1); PG8_SCHED; PG8_LDA(At, 0, 0); PG8_STAGE(PG8_SA(1, 1), a1 + hstepA, voffA);
            PG8_WAIT_V(8); PG8_WAIT_L(0); PG8_BAR; PG8_MMA(0, 0, At, B0); PG8_MMA(0, 1, At, B1); PG8_BAR; PG8_SCHED;
            PG8_LDA(At, 0, 1); PG8_STAGE(PG8_SB(0, 0), b2, voffB); PG8_STAGE(PG8_SB(0, 1), b2 + hstepB, voffB); PG8_STAGE(PG8_SA(0, 0), a2, voffA);
            PG8_WAIT_V(8); PG8_WAIT_L(0); PG8_BAR; PG8_MMA(1, 0, At, B0); PG8_MMA(1, 1, At, B1); PG8_BAR; PG8_SCHED;
            PG8_LDB(B0, 1, 0); PG8_LDB(B1, 1, 1); PG8_SCHED; PG8_LDA(At, 1, 0); PG8_STAGE(PG8_SA(0, 1), a2 + hstepA, voffA);
            PG8_WAIT_V(8); PG8_WAIT_L(0); PG8_BAR; PG8_MMA(0, 0, At, B0); PG8_MMA(0, 1, At, B1); PG8_BAR; PG8_SCHED;
            PG8_LDA(At, 1, 1); PG8_STAGE(PG8_SB(1, 0), b3, voffB); PG8_STAGE(PG8_SB(1, 1), b3 + hstepB, voffB); PG8_STAGE(PG8_SA(1, 0), a3, voffA);
            PG8_WAIT_V(8); PG8_WAIT_L(0); PG8_BAR; PG8_MMA(1, 0, At, B0); PG8_MMA(1, 1, At, B1); PG8_BAR; PG8_SCHED;
        }
        if (wr == 0) PG8_BAR;
        E(acc, cur, wr, wc, fr, fq, lds, ui);
        if (!has_next) break;
        if (!(Epi::KEEP && cur.kh == 0)) {
#pragma unroll
            for (int a = 0; a < 2; ++a)
#pragma unroll
                for (int b = 0; b < 2; ++b)
#pragma unroll
                    for (int m = 0; m < 4; ++m)
#pragma unroll
                        for (int n = 0; n < 2; ++n) acc[a][b][m][n] = (f32x4){0.f, 0.f, 0.f, 0.f};
        }
        cur = nxt; cA = nA; cB = nB; ++ui;
        E.prep(lds, cur, ui);
        if (wr == 1) PG8_BAR;
    }
    PG8_WAIT_V(0);
    PG8_BAR;
#undef PG8_SA
#undef PG8_SB
#undef PG8_STAGE
#undef PG8_LDA
#undef PG8_LDB
#undef PG8_MMA
#undef PG8_WAIT_V
#undef PG8_WAIT_L
#undef PG8_BAR
#undef PG8_SCHED
#undef PG8_UA
#undef PG8_UB
}

template <int NP> struct EpiSwiglu {
    static constexpr bool KEEP = false;
    bf16_t* H; const float* ss;
    __device__ __forceinline__ void prep(LAS unsigned char* lds, const Unit& u, int ui) const { rs_prep<NP>(lds, ss, u.pm, ui); }
    __device__ __forceinline__ void operator()(f32x4 (&acc)[2][2][4][2], const Unit& u, int wr, int wc, int fr, int fq, LAS unsigned char* lds, int ui) const {
        const int row0 = u.pm * BM + wr * 64 + fr, col0 = u.pn * 128 + wc * 32 + 8 * fq;
#pragma unroll
        for (int ai = 0; ai < 2; ++ai)
#pragma unroll
            for (int m = 0; m < 4; ++m) {
                const int row = row0 + ai * HALF + m * 16; const float r = rs_get(lds, ui, ai * HALF + wr * 64 + m * 16 + fr);
                float hv[8];
#pragma unroll
                for (int n = 0; n < 2; ++n)
#pragma unroll
                    for (int e = 0; e < 4; ++e) { const float gg = acc[ai][0][m][n][e] * r, uu = acc[ai][1][m][n][e] * r; hv[n * 4 + e] = gg * uu * sigmoidf_(gg); }
                u32x4 w; w.x = cvtpk(hv[0], hv[1]); w.y = cvtpk(hv[2], hv[3]); w.z = cvtpk(hv[4], hv[5]); w.w = cvtpk(hv[6], hv[7]);
                __builtin_nontemporal_store(w, (u32x4*)(H + (size_t)row * FF + col0));
            }
    }
};
template <bool SRC_BF16> struct EpiResid {
    static constexpr bool KEEP = false;
    const void* src; bf16_t* xb; float* ssout; float alpha;
    __device__ __forceinline__ void prep(LAS unsigned char*, const Unit&, int) const {}
    __device__ __forceinline__ void operator()(f32x4 (&acc)[2][2][4][2], const Unit& u, int wr, int wc, int fr, int fq, LAS unsigned char*, int) const {
        const int row0 = u.pm * BM + wr * 64 + fr, col0 = u.pn * BM + wc * 32 + 8 * fq;
#pragma unroll
        for (int ai = 0; ai < 2; ++ai)
#pragma unroll
            for (int m = 0; m < 4; ++m) {
                const int row = row0 + ai * HALF + m * 16; float sq = 0.f;
#pragma unroll
                for (int bj = 0; bj < 2; ++bj) {
                    const size_t off = (size_t)row * DM + col0 + bj * HALF;
                    f32x4 a, b;
                    if (SRC_BF16) { const u32x4 w = *(const u32x4*)((const bf16_t*)src + off);
                        a = (f32x4){bflo(w.x), bfhi(w.x), bflo(w.y), bfhi(w.y)}; b = (f32x4){bflo(w.z), bfhi(w.z), bflo(w.w), bfhi(w.w)}; }
                    else { a = *(const f32x4*)((const float*)src + off); b = *(const f32x4*)((const float*)src + off + 4); }
                    const f32x4 o0 = a + acc[ai][bj][m][0] * alpha, o1 = b + acc[ai][bj][m][1] * alpha;
                    sq += (o0[0] * o0[0] + o0[1] * o0[1]) + (o0[2] * o0[2] + o0[3] * o0[3]) + (o1[0] * o1[0] + o1[1] * o1[1]) + (o1[2] * o1[2] + o1[3] * o1[3]);
                    u32x4 w; w.x = cvtpk(o0[0], o0[1]); w.y = cvtpk(o0[2], o0[3]); w.z = cvtpk(o1[0], o1[1]); w.w = cvtpk(o1[2], o1[3]); __builtin_nontemporal_store(w, (u32x4*)(xb + off));
                }
                sq = sum_x32(sum_x16(sq));
                if (fq == 0) ssout[(size_t)(u.pn * 4 + wc) * M + row] = sq;
                if (m == 3) asm volatile("" ::: "memory");
            }
    }
};
template <int NP> struct EpiWin {
    static constexpr bool KEEP = false;
    bf16_t* QKV; const float* ss; const float *qn_a, *kn_a, *qn_b, *kn_b; const float* rope;
    __device__ __forceinline__ void prep(LAS unsigned char* lds, const Unit& u, int ui) const { rs_prep<NP>(lds, ss, u.pm, ui); }
    __device__ __forceinline__ void operator()(f32x4 (&acc)[2][2][4][2], const Unit& u, int wr, int wc, int fr, int fq, LAS unsigned char* lds, int ui) const {
        const int pn = u.pn; int type; const float* gain = qn_a; float qs = 1.0f;
        if (pn < 2) { type = 0; gain = qn_a; qs = QSCALE; } else if (pn < 4) { type = 0; gain = kn_a; } else if (pn < 6) { type = 2; }
        else if (pn < 8) { type = 1; gain = qn_b; qs = QSCALE; } else if (pn < 10) { type = 1; gain = kn_b; } else if (pn < 12) { type = 2; } else { type = 3; }
        f32x4 gv[2][2];
#pragma unroll
        for (int bj = 0; bj < 2; ++bj)
#pragma unroll
            for (int n = 0; n < 2; ++n) gv[bj][n] = *(const f32x4*)(gain + bj * 32 + 8 * fq + 4 * n);
        const int row0 = u.pm * BM + wr * 64 + fr, colb = pn * 256 + wc * 64 + 8 * fq;
#pragma unroll
        for (int ai = 0; ai < 2; ++ai)
#pragma unroll
            for (int m = 0; m < 4; ++m) {
                const int row = row0 + ai * HALF + m * 16; const float r = rs_get(lds, ui, ai * HALF + wr * 64 + m * 16 + fr);
                f32x4 v[2][2];
#pragma unroll
                for (int bj = 0; bj < 2; ++bj)
#pragma unroll
                    for (int n = 0; n < 2; ++n) v[bj][n] = acc[ai][bj][m][n] * r;
                if (type <= 1) {
                    float sq = 0.f;
#pragma unroll
                    for (int bj = 0; bj < 2; ++bj)
#pragma unroll
                        for (int n = 0; n < 2; ++n) sq += (v[bj][n][0] * v[bj][n][0] + v[bj][n][1] * v[bj][n][1]) + (v[bj][n][2] * v[bj][n][2] + v[bj][n][3] * v[bj][n][3]);
                    sq = sum_x32(sum_x16(sq));
                    const float hn = rsqrtf(sq * (1.0f / 64.0f) + EPS);
#pragma unroll
                    for (int bj = 0; bj < 2; ++bj)
#pragma unroll
                        for (int n = 0; n < 2; ++n) v[bj][n] = v[bj][n] * hn * gv[bj][n];
                    if (type == 1) {
                        const float* cs = rope + (size_t)(row & (SEQ - 1)) * 16;
#pragma unroll
                        for (int n = 0; n < 2; ++n) {
                            const f32x4 c0 = *(const f32x4*)(cs + n * 8), c1 = *(const f32x4*)(cs + n * 8 + 4);
                            f32x4 pr;
#pragma unroll
                            for (int e = 0; e < 4; ++e) pr[e] = get_x16(v[0][n][e], fq & 1);
                            const float sg = (fq == 0) ? -1.0f : 1.0f;
                            f32x4 o;
                            o[0] = v[0][n][0] * c0[0] + sg * pr[0] * c0[1]; o[1] = v[0][n][1] * c0[2] + sg * pr[1] * c0[3];
                            o[2] = v[0][n][2] * c1[0] + sg * pr[2] * c1[1]; o[3] = v[0][n][3] * c1[2] + sg * pr[3] * c1[3];
                            if (fq < 2) v[0][n] = o;
                        }
                    }
#pragma unroll
                    for (int bj = 0; bj < 2; ++bj)
#pragma unroll
                        for (int n = 0; n < 2; ++n) v[bj][n] = v[bj][n] * qs;
                } else if (type == 3) {
#pragma unroll
                    for (int n = 0; n < 2; ++n)
#pragma unroll
                        for (int e = 0; e < 4; ++e) { const float ea = 1.0f + fast_exp2(-v[0][n][e] * LOG2E), eb = 1.0f + fast_exp2(-v[1][n][e] * LOG2E);
                            v[0][n][e] = eb * fast_rcp(ea); v[1][n][e] = fast_rcp(eb); }
                }
#pragma unroll
                for (int bj = 0; bj < 2; ++bj) {
                    u32x4 w; w.x = cvtpk(v[bj][0][0], v[bj][0][1]); w.y = cvtpk(v[bj][0][2], v[bj][0][3]); w.z = cvtpk(v[bj][1][0], v[bj][1][1]); w.w = cvtpk(v[bj][1][2], v[bj][1][3]);
                    __builtin_nontemporal_store(w, (u32x4*)(QKV + (size_t)row * NIN + (type == 3 ? 3072 + bj * 1024 + (pn - 12) * 128 + wc * 32 + 8 * fq : colb + bj * 32)));
                }
                if (m & 1) asm volatile("" ::: "memory");
            }
    }
};
struct EpiUp {
    static constexpr bool KEEP = true;
    const bf16_t* QKV; bf16_t* Y;
    __device__ __forceinline__ void prep(LAS unsigned char*, const Unit&, int) const {}
    __device__ __forceinline__ void operator()(f32x4 (&acc)[2][2][4][2], const Unit& u, int wr, int wc, int fr, int fq, LAS unsigned char*, int) const {
        const int row0 = u.pm * BM + wr * 64 + fr, col0 = u.pn * BM + wc * 32 + 8 * fq;
#pragma unroll
        for (int ai = 0; ai < 2; ++ai)
#pragma unroll
            for (int m = 0; m < 4; ++m) {
                const int row = row0 + ai * HALF + m * 16;
#pragma unroll
                for (int bj = 0; bj < 2; ++bj) {
                    const int c = col0 + bj * HALF;
                    const u32x4 sb = *(const u32x4*)(QKV + (size_t)row * NIN + (u.kh == 0 ? 3072 : 4096) + c);
                    float fb[8] = {bflo(sb.x), bfhi(sb.x), bflo(sb.y), bfhi(sb.y), bflo(sb.z), bfhi(sb.z), bflo(sb.w), bfhi(sb.w)};
                    if (u.kh == 0) {
#pragma unroll
                        for (int n = 0; n < 2; ++n)
#pragma unroll
                            for (int e = 0; e < 4; ++e) acc[ai][bj][m][n][e] *= fb[n * 4 + e];
                    } else {
                        float y[8];
#pragma unroll
                        for (int n = 0; n < 2; ++n)
#pragma unroll
                            for (int e = 0; e < 4; ++e) y[n * 4 + e] = acc[ai][bj][m][n][e] * fb[n * 4 + e];
                        u32x4 w; w.x = cvtpk(y[0], y[1]); w.y = cvtpk(y[2], y[3]); w.z = cvtpk(y[4], y[5]); w.w = cvtpk(y[6], y[7]);
                        __builtin_nontemporal_store(w, (u32x4*)(Y + (size_t)row * DM + c));
                    }
                }
                if (m == 3) asm volatile("" ::: "memory");
            }
    }
};
}

namespace att {
template <int KIND> struct AK;
template <> struct AK<0> { static constexpr int DVB = 2, ROWB = 128, KP = 144, VP = 192, NLD = 1; };
template <> struct AK<1> { static constexpr int DVB = 4, ROWB = 256, KP = 272, VP = 320, NLD = 2; };
constexpr int AL_K = 0, AL_V = 34816, AL_X = 0, AL_T = 96256;
typedef short v4i16_t __attribute__((ext_vector_type(4)));
__device__ __forceinline__ s16x4 vtr(const LAS unsigned char* p) { return __builtin_bit_cast(s16x4, __builtin_amdgcn_ds_read_tr16_b64_v4i16((LAS v4i16_t*)p)); }
__device__ __forceinline__ constexpr int cr(int i) { return (i & 3) + 8 * (i >> 2); }

__device__ __forceinline__ float max3f(float a, float b, float c) { float r; asm("v_max3_f32 %0, %1, %2, %3" : "=v"(r) : "v"(a), "v"(b), "v"(c)); return r; }

template <int DVB, int KP>
__device__ __forceinline__ void qk_softmax(const LAS unsigned char* Kl, const bf16x8 (&qf)[4], f32x16 (&O)[DVB], float& mrun, float& lrun, bf16x8 (&pk)[4],
                                           bool first, int lane, int biasmode, const LAS float* tb, float cbias) {
    const int r = lane & 31, h = lane >> 5;
    const LAS unsigned char* kp = Kl + r * KP + h * 16;
    f32x16 p0, p1, zero16;
#pragma unroll
    for (int i = 0; i < 16; ++i) zero16[i] = 0.f;
#pragma unroll
    for (int ks = 0; ks < 4; ++ks) {
        const bf16x8 a0 = *(const LAS bf16x8*)(kp + ks * 32), a1 = *(const LAS bf16x8*)(kp + 32 * KP + ks * 32);
        if (ks == 0) { p0 = __builtin_amdgcn_mfma_f32_32x32x16_bf16(a0, qf[0], zero16, 0, 0, 0); p1 = __builtin_amdgcn_mfma_f32_32x32x16_bf16(a1, qf[0], zero16, 0, 0, 0); }
        else { p0 = __builtin_amdgcn_mfma_f32_32x32x16_bf16(a0, qf[ks], p0, 0, 0, 0); p1 = __builtin_amdgcn_mfma_f32_32x32x16_bf16(a1, qf[ks], p1, 0, 0, 0); }
    }
    if (biasmode == 1) {
#pragma unroll
        for (int i = 0; i < 16; ++i) { p0[i] += tb[-cr(i)]; p1[i] += tb[-32 - cr(i)]; }
    } else if (biasmode == 2) {
#pragma unroll
        for (int i = 0; i < 16; ++i) { p0[i] += cbias; p1[i] += cbias; }
    }
    asm volatile("s_nop 15\n\ts_nop 7" : "+v"(p0), "+v"(p1));
    float ta = max3f(p0[0], p0[1], p1[0]), tbm = max3f(p0[2], p0[3], p1[1]); ta = max3f(ta, p1[2], p1[3]);
#pragma unroll
    for (int i = 4; i < 16; i += 4) { ta = max3f(ta, p0[i], p0[i + 1]); tbm = max3f(tbm, p0[i + 2], p0[i + 3]); ta = max3f(ta, p1[i], p1[i + 1]); tbm = max3f(tbm, p1[i + 2], p1[i + 3]); }
    float tm = max3f(ta, tbm, tbm);
    { auto rr = __builtin_amdgcn_permlane32_swap(__float_as_uint(tm), __float_as_uint(tm), false, false); tm = max3f(__uint_as_float(rr[0]), __uint_as_float(rr[1]), tm); }
    if (first || (__builtin_amdgcn_ballot_w64(tm > mrun + 8.0f) != 0ull)) {
        const float mnew = first ? tm : fmaxf(mrun, tm);
        if (!first) { const float alpha = fast_exp2(mrun - mnew);
#pragma unroll
            for (int d = 0; d < DVB; ++d)
#pragma unroll
                for (int i = 0; i < 16; ++i) O[d][i] *= alpha;
            lrun *= alpha; }
        mrun = mnew;
    }
    float s0 = 0.f, s1 = 0.f;
#pragma unroll
    for (int i = 0; i < 16; ++i) { p0[i] = fast_exp2(p0[i] - mrun); p1[i] = fast_exp2(p1[i] - mrun); s0 += p0[i]; s1 += p1[i]; }
    lrun += s0 + s1;
    { u32x4 w;
      w.x = cvtpk(p0[0], p0[1]); w.y = cvtpk(p0[2], p0[3]); w.z = cvtpk(p0[4], p0[5]); w.w = cvtpk(p0[6], p0[7]); pk[0] = __builtin_bit_cast(bf16x8, w);
      w.x = cvtpk(p0[8], p0[9]); w.y = cvtpk(p0[10], p0[11]); w.z = cvtpk(p0[12], p0[13]); w.w = cvtpk(p0[14], p0[15]); pk[1] = __builtin_bit_cast(bf16x8, w);
      w.x = cvtpk(p1[0], p1[1]); w.y = cvtpk(p1[2], p1[3]); w.z = cvtpk(p1[4], p1[5]); w.w = cvtpk(p1[6], p1[7]); pk[2] = __builtin_bit_cast(bf16x8, w);
      w.x = cvtpk(p1[8], p1[9]); w.y = cvtpk(p1[10], p1[11]); w.z = cvtpk(p1[12], p1[13]); w.w = cvtpk(p1[14], p1[15]); pk[3] = __builtin_bit_cast(bf16x8, w); }
}
template <int DVB, int VP>
__device__ __forceinline__ void pv_tile(const LAS unsigned char* Vl, const bf16x8 (&pk)[4], f32x16 (&O)[DVB], int lane) {
    const int g = lane >> 4, i16 = lane & 15, q = i16 >> 2, pp = i16 & 3;
    const LAS unsigned char* vp = Vl + (4 * (g >> 1) + q) * VP + (16 * (g & 1) + 4 * pp) * 2;
#pragma unroll
    for (int f = 0; f < 4; ++f)
#pragma unroll
        for (int d = 0; d < DVB; ++d) {
            const int key0 = 32 * (f >> 1) + 16 * (f & 1);
            const s16x4 lo = vtr(vp + key0 * VP + d * 64), hi = vtr(vp + (key0 + 8) * VP + d * 64);
            const bf16x8 vf = __builtin_shufflevector(lo, hi, 0, 1, 2, 3, 4, 5, 6, 7);
            O[d] = __builtin_amdgcn_mfma_f32_32x32x16_bf16(vf, pk[f], O[d], 0, 0, 0);
        }
}

template <int KIND>
__device__ __forceinline__ void attn_unit(LAS unsigned char* lds, const bf16_t* QKV, bf16_t* OUT, int b, int hd, int blk, const float* relb, float lam, const float* gsub) {
    using P = AK<KIND>;
    constexpr int DVB = P::DVB, KP = P::KP, VP = P::VP, NLD = P::NLD, CPR = P::ROWB / 16;
    const int tid = threadIdx.x, lane = tid & 63, wid = __builtin_amdgcn_readfirstlane(tid >> 6), r = lane & 31, h = lane >> 5;
    int qbase, qc, tlo, thi, klo, comp = 0, rg = 0, qcol, kcol, vcol, ocol;
    if (KIND == 0) { const int c0 = blk * 4; qc = c0 + (wid >> 1); qbase = qc * 64 + (wid & 1) * 32; tlo = c0 - 8 < 0 ? 0 : c0 - 8; thi = c0 + 3; klo = qc - 8;
        qcol = hd * 64; kcol = 512 + hd * 64; vcol = 1024 + hd * 64; ocol = hd * 64; }
    else { comp = wid >> 2; rg = wid & 3; qbase = blk * 128 + rg * 32; qc = qbase >> 6; tlo = 0; thi = 2 * blk + 1; klo = 0;
        qcol = 1536 + (2 * hd + comp) * 64; kcol = 2048 + hd * 128; vcol = 2560 + hd * 128; ocol = 512 + hd * 128; }
    if (klo < tlo) klo = tlo;
    const bool skew = wid >= 4;
    const size_t tok0 = (size_t)b * SEQ;
    LAS float* t2 = (LAS float*)(lds + AL_T);
    float cbias = 0.f;
    if (KIND == 0) {
        for (int i = tid; i < 640; i += 512) { int rel = i - 63; rel = rel > 256 ? 256 : rel; t2[i] = relb[(rel + 256) * 8 + hd] * LOG2E; }
        cbias = relb[512 * 8 + hd] * LOG2E;
    }
    bf16x8 qf[4];
    { const bf16_t* qp = QKV + (tok0 + qbase + r) * NIN + qcol + h * 8;
#pragma unroll
      for (int ks = 0; ks < 4; ++ks) qf[ks] = *(const bf16x8*)(qp + ks * 16); }
    u32x4 kregA[NLD], vregA[NLD], kregB[NLD], vregB[NLD];
#define ATT_LOAD(kr_, vr_, kc_) do { _Pragma("unroll") for (int i_ = 0; i_ < NLD; ++i_) { const int idx_ = tid + 512 * i_, row_ = idx_ / CPR, ch_ = idx_ % CPR; \
        const bf16_t* s_ = QKV + (tok0 + (size_t)(kc_) * 64 + row_) * NIN + ch_ * 8; kr_[i_] = *(const u32x4*)(s_ + kcol); vr_[i_] = *(const u32x4*)(s_ + vcol); } } while (0)
#define ATT_STORE(kr_, vr_, kb_, vb_) do { _Pragma("unroll") for (int i_ = 0; i_ < NLD; ++i_) { const int idx_ = tid + 512 * i_, row_ = idx_ / CPR, ch_ = idx_ % CPR; \
        *(LAS u32x4*)(lds + AL_K + (kb_) * 64 * KP + row_ * KP + ch_ * 16) = kr_[i_]; *(LAS u32x4*)(lds + AL_V + (vb_) * 64 * VP + row_ * VP + ch_ * 16) = vr_[i_]; } } while (0)
    ATT_LOAD(kregA, vregA, tlo); ATT_STORE(kregA, vregA, 0, 0);
    ATT_LOAD(kregB, vregB, tlo + 1);
    __syncthreads();
    f32x16 O[DVB]; bf16x8 pk[4];
#pragma unroll
    for (int d = 0; d < DVB; ++d)
#pragma unroll
        for (int i = 0; i < 16; ++i) O[d][i] = 0.f;
#pragma unroll
    for (int f = 0; f < 4; ++f) pk[f] = (bf16x8){0, 0, 0, 0, 0, 0, 0, 0};
    float mrun = 0.f, lrun = 0.f;
    int vprev = 2, vcur = 0, vnext = 1;
#define ATT_STEP(kc_, LDK_, LDV_, STK_, STV_) do { const int kc = (kc_); const int kb = (kc - tlo) & 1; \
        if (kc + 2 <= thi) ATT_LOAD(LDK_, LDV_, kc + 2); \
        const bool a1 = (kc >= klo && kc <= qc), a0 = (kc - 1 >= klo && kc - 1 <= qc); \
        const LAS unsigned char* Kl = lds + AL_K + kb * 64 * KP + (KIND == 1 ? comp * 128 : 0); \
        int biasmode = 0; const LAS float* tb = t2; \
        if (KIND == 0) { biasmode = (kc <= qc - 5) ? 2 : 1; tb = t2 + (qbase - kc * 64 + 63) + r - 4 * h; } \
        if (skew && a0) pv_tile<DVB, VP>(lds + AL_V + vprev * 64 * VP, pk, O, lane); \
        if (a1) qk_softmax<DVB, KP>(Kl, qf, O, mrun, lrun, pk, kc == klo, lane, biasmode, tb, cbias); \
        if (!skew && a1) pv_tile<DVB, VP>(lds + AL_V + vcur * 64 * VP, pk, O, lane); \
        if (kc < thi) ATT_STORE(STK_, STV_, kb ^ 1, vnext); \
        __syncthreads(); \
        { const int t_ = vprev; vprev = vcur; vcur = vnext; vnext = t_; } } while (0)
    for (int kc2 = tlo; kc2 <= thi; kc2 += 2) {
        ATT_STEP(kc2, kregA, vregA, kregB, vregB);
        ATT_STEP(kc2 + 1, kregB, vregB, kregA, vregA);
    }
#undef ATT_STEP
#undef ATT_LOAD
#undef ATT_STORE
    if (skew && thi >= klo && thi <= qc) pv_tile<DVB, VP>(lds + AL_V + vprev * 64 * VP, pk, O, lane);
    __syncthreads();
    const float lt = sum_x32(lrun), inv = 1.0f / lt;
    bf16_t* op = OUT + (tok0 + qbase + r) * DM + ocol + 4 * h;
    if (KIND == 0) {
#pragma unroll
        for (int d = 0; d < DVB; ++d)
#pragma unroll
            for (int g4 = 0; g4 < 4; ++g4) { u32x2 w; w.x = cvtpk(O[d][4 * g4] * inv, O[d][4 * g4 + 1] * inv); w.y = cvtpk(O[d][4 * g4 + 2] * inv, O[d][4 * g4 + 3] * inv);
                *(u32x2*)(op + 32 * d + 8 * g4) = w; }
    } else {
        LAS float* X = (LAS float*)(lds + AL_X) + rg * 4096 + lane;
        if (comp == 1) { const float sc = lam * inv;
#pragma unroll
            for (int d = 0; d < DVB; ++d)
#pragma unroll
                for (int i = 0; i < 16; ++i) X[(d * 16 + i) * 64] = O[d][i] * sc; }
        __syncthreads();
        if (comp == 0) {
            float sq = 0.f;
#pragma unroll
            for (int d = 0; d < DVB; ++d)
#pragma unroll
                for (int i = 0; i < 16; ++i) { const float o = O[d][i] * inv - X[(d * 16 + i) * 64]; O[d][i] = o; sq += o * o; }
            sq = sum_x32(sq);
            const float rn = rsqrtf(sq * (1.0f / 128.0f) + EPS) * 0.8f;
#pragma unroll
            for (int d = 0; d < DVB; ++d)
#pragma unroll
                for (int g4 = 0; g4 < 4; ++g4) { const f32x4 gs = *(const f32x4*)(gsub + 32 * d + 8 * g4 + 4 * h);
                    u32x2 w; w.x = cvtpk(O[d][4 * g4] * rn * gs[0], O[d][4 * g4 + 1] * rn * gs[1]); w.y = cvtpk(O[d][4 * g4 + 2] * rn * gs[2], O[d][4 * g4 + 3] * rn * gs[3]);
                    *(u32x2*)(op + 32 * d + 8 * g4) = w; }
        }
        __syncthreads();
    }
}
}

#define XB_TMO      128
#define XB_XCNT(j)  (256  + 64 * (j))
#define XB_XSUB(j)  (1280 + 64 * (j))
#define XB_XGEN(j)  (2304 + 64 * (j))
#define XB_TOP      3328
#define XB_TOPGEN   3392
#define XCD_BAR_WORDS 3456
#define XB_SPIN_CAP (1u << 18)
__device__ __forceinline__ unsigned xb_ld(unsigned* p)              { return __hip_atomic_load(p, __ATOMIC_RELAXED, __HIP_MEMORY_SCOPE_AGENT); }
__device__ __forceinline__ unsigned xb_add(unsigned* p, unsigned v) { return __hip_atomic_fetch_add(p, v, __ATOMIC_RELAXED, __HIP_MEMORY_SCOPE_AGENT); }
__device__ __forceinline__ unsigned xb_xcc_id() { return (unsigned)__builtin_amdgcn_s_getreg((3 << 11) | 20) & 0xFu; }
#define XB_SPIN(cond, bar) do { unsigned _sp = 0; while (cond) { __builtin_amdgcn_s_sleep(1); \
    if ((++_sp & 255u) == 0u) { if (xb_ld(&(bar)[XB_TMO])) break; if (_sp > XB_SPIN_CAP) { atomicAdd(&(bar)[XB_TMO], 1u); break; } } } } while (0)
struct XcdBarrier { unsigned* bar; unsigned x; volatile LAS unsigned* st; };
__device__ __forceinline__ XcdBarrier xcd_barrier_post(unsigned* bar, volatile LAS unsigned* st) {
    XcdBarrier b; b.bar = bar; b.x = xb_xcc_id(); b.st = st;
    if (threadIdx.x == 0) (void)xb_add(&bar[XB_XCNT(b.x)], 1u);
    return b;
}
__device__ __forceinline__ void xcd_barrier_complete(unsigned* bar, unsigned x, unsigned& nloc, unsigned& nx) {
    const unsigned G = gridDim.x * gridDim.y * gridDim.z;
    unsigned sum, cnt, mine, sp = 0u;
    for (;;) {
        sum = 0u; cnt = 0u; mine = 0u;
#pragma unroll
        for (unsigned j = 0; j < 16; ++j) { const unsigned c = xb_ld(&bar[XB_XCNT(j)]); sum += c; cnt += (c > 0u) ? 1u : 0u; mine = (j == x) ? c : mine; }
        if (sum == G) break;
        __builtin_amdgcn_s_sleep(1);
        if ((++sp & 255u) == 0u) { if (xb_ld(&bar[XB_TMO])) break; if (sp > XB_SPIN_CAP) { atomicAdd(&bar[XB_TMO], 1u); break; } }
    }
    nloc = mine > 0u ? mine : 1u; nx = cnt > 0u ? cnt : 1u;
}
__device__ __forceinline__ void xcd_barrier(const XcdBarrier& b) {
    asm volatile("s_waitcnt vmcnt(0)" ::: "memory");
    __syncthreads();
    if (threadIdx.x == 0) {
        unsigned* bar = b.bar;
        __builtin_amdgcn_s_waitcnt(0);
        unsigned nloc = b.st[0], nx = b.st[1];
        if (nloc == 0u) { xcd_barrier_complete(bar, b.x, nloc, nx); b.st[0] = nloc; b.st[1] = nx; }
        const unsigned old = xb_add(&bar[XB_XSUB(b.x)], 1u);
        const unsigned gen = old / nloc;
        if (old + 1u == (gen + 1u) * nloc) {
            __builtin_amdgcn_fence(__ATOMIC_RELEASE, "agent");
            asm volatile("s_waitcnt vmcnt(0)" ::: "memory");
            const unsigned og = xb_add(&bar[XB_TOP], 1u);
            const unsigned tg = og / nx;
            if (og + 1u == (tg + 1u) * nx) xb_add(&bar[XB_TOPGEN], 1u);
            else XB_SPIN(xb_ld(&bar[XB_TOPGEN]) == tg, bar);
            __builtin_amdgcn_fence(__ATOMIC_ACQUIRE, "agent");
            xb_add(&bar[XB_XGEN(b.x)], 1u);
            asm volatile("s_waitcnt vmcnt(0)" ::: "memory");
        } else {
            XB_SPIN(xb_ld(&bar[XB_XGEN(b.x)]) == gen, bar);
            __builtin_amdgcn_fence(__ATOMIC_ACQUIRE, "agent");
            asm volatile("s_waitcnt vmcnt(0)" ::: "memory");
        }
    }
    __syncthreads();
}

constexpr int NWAVES = 8;
constexpr int LDS_BYTES = 147456;
constexpr int LDS_BARST = 147440;
constexpr int N_PHASES = 10;
constexpr size_t OFF_QKV = 0;
constexpr size_t OFF_XB = 335544320;
constexpr size_t OFF_Y = OFF_XB + 67108864;
constexpr size_t OFF_WGU1 = OFF_Y + 67108864;
constexpr size_t OFF_WD1 = OFF_WGU1 + 11534336;
constexpr size_t OFF_WIN = OFF_WD1 + 5767168;
constexpr size_t OFF_WUP = OFF_WIN + 10485760;
constexpr size_t OFF_WOUT = OFF_WUP + 2097152;
constexpr size_t OFF_WGU2 = OFF_WOUT + 2097152;
constexpr size_t OFF_WD2 = OFF_WGU2 + 11534336;
constexpr size_t OFF_SS = OFF_WD2 + 5767168;
constexpr size_t SS_SET = (size_t)16 * M * 4;
constexpr size_t OFF_ROPE = OFF_SS + 4 * SS_SET;
constexpr size_t OFF_BAR = OFF_ROPE + 262144;
constexpr size_t BAR_BYTES = 16384;
constexpr size_t WS_END = OFF_BAR + BAR_BYTES;

struct Args { const float* in[23]; float* out; unsigned char* ws; int ph_lo, ph_hi; };

__device__ __forceinline__ void tr_item(const float* __restrict__ W, int ldw, int k0, int sc0, const float* __restrict__ g, bf16_t* WT, int ldo, int orow0, int kout0, LAS float* scr, int lane) {
    const int kr = lane >> 3, c4 = lane & 7;
    f32x4 v[8];
#pragma unroll
    for (int i = 0; i < 8; ++i) v[i] = *(const f32x4*)(W + (size_t)(k0 + 8 * i + kr) * ldw + sc0 + 4 * c4);
    if (g) {
#pragma unroll
        for (int i = 0; i < 8; ++i) v[i] = v[i] * g[k0 + 8 * i + kr];
    }
#pragma unroll
    for (int i = 0; i < 8; ++i) { LAS float* d = scr + (8 * i + kr) * 33 + 4 * c4; d[0] = v[i][0]; d[1] = v[i][1]; d[2] = v[i][2]; d[3] = v[i][3]; }
    asm volatile("s_waitcnt lgkmcnt(0)" ::: "memory");
    const int c = lane & 7;
#pragma unroll
    for (int j = 0; j < 4; ++j) { const int n = (lane >> 3) + 8 * j; const LAS float* s = scr + (8 * c) * 33 + n;
        u32x4 o; o.x = cvtpk(s[0 * 33], s[1 * 33]); o.y = cvtpk(s[2 * 33], s[3 * 33]); o.z = cvtpk(s[4 * 33], s[5 * 33]); o.w = cvtpk(s[6 * 33], s[7 * 33]);
        *(u32x4*)(WT + (size_t)(orow0 + n) * ldo + kout0 + k0 + 8 * c) = o; }
    asm volatile("s_waitcnt lgkmcnt(0)" ::: "memory");
}
__device__ __forceinline__ void item_gu(const float* W, const float* g, bf16_t* WT, int it, LAS float* scr, int lane) {
    const int kb = it / 176, nb = it % 176, pn = nb >> 3, wb = nb & 7, bj = wb >> 2, j4 = wb & 3;
    tr_item(W, 2 * FF, kb * 64, bj * FF + pn * 128 + j4 * 32, g, WT, DM, nb * 32, 0, scr, lane);
}
__device__ __forceinline__ void item_win(const float* W, const float* g, bf16_t* WT, int it, LAS float* scr, int lane) {
    const int kb = it / 160, nb = it % 160, pn = nb >> 3, wb = nb & 7, bj = wb >> 2, wc = wb & 3;
    const int sc0 = pn < 12 ? pn * 256 + wc * 64 + bj * 32 : 3072 + bj * 1024 + (pn - 12) * 128 + wc * 32;
    tr_item(W, NIN, kb * 64, sc0, g, WT, DM, nb * 32, 0, scr, lane);
}
__device__ __forceinline__ void item_plain(const float* W, int ldw, int nblk, bf16_t* WT, int ldo, int kout0, int it, LAS float* scr, int lane) {
    const int kb = it / nblk, nb = it % nblk;
    tr_item(W, ldw, kb * 64, nb * 32, nullptr, WT, ldo, nb * 32, kout0, scr, lane);
}

__global__ void __launch_bounds__(NWAVES * 64, 2) fwd_kernel(Args args) {
    extern __shared__ __attribute__((aligned(16))) unsigned char lds_raw[];
    LAS unsigned char* lds = (LAS unsigned char*)lds_raw;
    const int tid = threadIdx.x, lane = tid & 63, wave = __builtin_amdgcn_readfirstlane(tid >> 6);
    const int G = gridDim.x, gw = blockIdx.x * NWAVES + wave, NGW = G * NWAVES;
    unsigned char* ws = args.ws;
    const float* x = args.in[0]; const float* g_ffn1 = args.in[1]; const float* w_gu1 = args.in[2]; const float* w_d1 = args.in[3]; const float* g_mix = args.in[4];
    const float* w_in = args.in[5]; const float* qn_a = args.in[6]; const float* kn_a = args.in[7]; const float* rel_bias = args.in[8]; const float* qn_b = args.in[9];
    const float* kn_b = args.in[10]; const float* lq1 = args.in[11]; const float* lk1 = args.in[12]; const float* lq2 = args.in[13]; const float* lk2 = args.in[14];
    const float* g_sub = args.in[15]; const float* w_up_a = args.in[16]; const float* w_up_b = args.in[17]; const float* w_out = args.in[18]; const float* g_ffn2 = args.in[19];
    const float* w_gu2 = args.in[20]; const float* w_d2 = args.in[21]; const float* g_final = args.in[22];
    float* out = args.out;
    bf16_t* QKV = (bf16_t*)(ws + OFF_QKV); bf16_t* Hb = (bf16_t*)(ws + OFF_QKV); bf16_t* XB = (bf16_t*)(ws + OFF_XB); bf16_t* Yb = (bf16_t*)(ws + OFF_Y);
    bf16_t* WGU1 = (bf16_t*)(ws + OFF_WGU1); bf16_t* WD1 = (bf16_t*)(ws + OFF_WD1); bf16_t* WIN = (bf16_t*)(ws + OFF_WIN); bf16_t* WUP = (bf16_t*)(ws + OFF_WUP);
    bf16_t* WOUT = (bf16_t*)(ws + OFF_WOUT); bf16_t* OAB = (bf16_t*)out;
    bf16_t* WGU2 = (bf16_t*)(ws + OFF_WGU2); bf16_t* WD2 = (bf16_t*)(ws + OFF_WD2);
    float* SS0 = (float*)(ws + OFF_SS); float* SS1 = (float*)(ws + OFF_SS + SS_SET); float* SS2 = (float*)(ws + OFF_SS + 2 * SS_SET); float* SS3 = (float*)(ws + OFF_SS + 3 * SS_SET);
    float* ROPE = (float*)(ws + OFF_ROPE);
    const int lo = args.ph_lo, hi = args.ph_hi;
#define IN(k) (lo <= (k) && (k) < hi)
#define SEAM(k) do { if (IN(k) && IN((k) + 1)) { xcd_barrier(gbar); } } while (0)
    if (tid < 2) ((volatile LAS unsigned*)(lds + LDS_BARST))[tid] = 0u;
    __syncthreads();
    XcdBarrier gbar; gbar.bar = (unsigned*)(ws + OFF_BAR); gbar.x = 0; gbar.st = nullptr;
    if (hi - lo > 1) gbar = xcd_barrier_post((unsigned*)(ws + OFF_BAR), (volatile LAS unsigned*)(lds + LDS_BARST));
    if (lo < 0) cg::this_grid().sync();

    if (IN(0)) {
        LAS float* scr = (LAS float*)(lds + wave * 16384);
        constexpr int I_GU = 16 * 176, I_DN = 44 * 32, I_WIN = 16 * 160, I_UP = 8 * 32, I_OUT = 16 * 32;
        constexpr int NITEMS = 2 * I_GU + 2 * I_DN + I_WIN + 2 * I_UP + I_OUT;
        for (int it = gw; it < NITEMS; it += NGW) {
            int r = it;
            if (r < I_GU) { item_gu(w_gu1, g_ffn1, WGU1, r, scr, lane); continue; } r -= I_GU;
            if (r < I_GU) { item_gu(w_gu2, g_ffn2, WGU2, r, scr, lane); continue; } r -= I_GU;
            if (r < I_WIN) { item_win(w_in, g_mix, WIN, r, scr, lane); continue; } r -= I_WIN;
            if (r < I_DN) { item_plain(w_d1, DM, 32, WD1, FF, 0, r, scr, lane); continue; } r -= I_DN;
            if (r < I_DN) { item_plain(w_d2, DM, 32, WD2, FF, 0, r, scr, lane); continue; } r -= I_DN;
            if (r < I_UP) { item_plain(w_up_a, DM, 32, WUP, DM, 0, r, scr, lane); continue; } r -= I_UP;
            if (r < I_UP) { item_plain(w_up_b, DM, 32, WUP, DM, 512, r, scr, lane); continue; } r -= I_UP;
            item_plain(w_out, DM, 32, WOUT, DM, 0, r, scr, lane);
        }
        for (int m0 = gw * 4; m0 < M; m0 += NGW * 4) {
            f32x4 v[4][4];
#pragma unroll
            for (int q = 0; q < 4; ++q) { const f32x4* xr = (const f32x4*)(x + (size_t)(m0 + q) * DM) + lane;
#pragma unroll
                for (int j = 0; j < 4; ++j) v[q][j] = xr[64 * j]; }
#pragma unroll
            for (int q = 0; q < 4; ++q) { float s = 0.f;
#pragma unroll
                for (int j = 0; j < 4; ++j) s += (v[q][j][0] * v[q][j][0] + v[q][j][1] * v[q][j][1]) + (v[q][j][2] * v[q][j][2] + v[q][j][3] * v[q][j][3]);
                s = wave_sum(s);
                if (lane == 0) SS0[m0 + q] = s;
                u32x2* o8 = (u32x2*)(XB + (size_t)(m0 + q) * DM) + lane;
#pragma unroll
                for (int j = 0; j < 4; ++j) { u32x2 w; w.x = cvtpk(v[q][j][0], v[q][j][1]); w.y = cvtpk(v[q][j][2], v[q][j][3]); o8[64 * j] = w; } }
        }
        for (int e = blockIdx.x * 512 + tid; e < SEQ * 8; e += G * 512) {
            const int pos = e >> 3, dd = e & 7;
            const float inv = exp2f(-(float)dd * 0.125f * 18.931568569324174f);
            const float ang = (float)pos * inv;
            const double rev = (double)ang * 0.15915494309189535;
            const float fr = (float)(rev - floor(rev));
            ROPE[e * 2] = __builtin_amdgcn_cosf(fr); ROPE[e * 2 + 1] = __builtin_amdgcn_sinf(fr);
        }
    }
    SEAM(0);
    if (IN(1)) {
        pg8::Gemm g{XB, WGU1, DM, DM, DM, 0, 0}; pg8::StaticOrder S; S.init(M, 2 * FF, G, (int)blockIdx.x, 1);
        pg8::EpiSwiglu<1> E{Hb, SS0};
        pg8::gemm_phase(lds, g, S, E);
    }
    SEAM(1);
    if (IN(2)) {
        pg8::Gemm g{Hb, WD1, FF, FF, FF, 0, 0}; pg8::StaticOrder S; S.init(M, DM, G, (int)blockIdx.x, 1);
        pg8::EpiResid<false> E{x, XB, SS1, 0.5f};
        pg8::gemm_phase(lds, g, S, E);
    }
    SEAM(2);
    if (IN(3)) {
        pg8::Gemm g{XB, WIN, DM, DM, DM, 0, 0}; pg8::StaticOrder S; S.init(M, NIN, G, (int)blockIdx.x, 1);
        pg8::EpiWin<16> E{QKV, SS1, qn_a, kn_a, qn_b, kn_b, ROPE};
        pg8::gemm_phase(lds, g, S, E);
    }
    SEAM(3);
    if (IN(4)) {
        const float s1 = wave_sum(lq1[lane] * lk1[lane]), s2 = wave_sum(lq2[lane] * lk2[lane]);
        const float lam = expf(s1) - expf(s2) + 0.2f;
        const int vcu = (G % 8 == 0) ? ((int)blockIdx.x % 8) * (G / 8) + (int)blockIdx.x / 8 : (int)blockIdx.x;
        for (int u = vcu; u < 1024; u += G) {
            const int grp = u & 15, hd = (u >> 4) & 7, b = u >> 7;
            att::attn_unit<0>(lds, QKV, OAB, b, hd, grp, rel_bias, 0.f, nullptr);
        }
        __syncthreads();
        for (int p = vcu; p < 512; p += G) {
            const int jj = p & 15, bh = p >> 4, hd = bh & 3, b = bh >> 2;
            att::attn_unit<1>(lds, QKV, OAB, b, hd, jj, nullptr, lam, g_sub);
            att::attn_unit<1>(lds, QKV, OAB, b, hd, 31 - jj, nullptr, lam, g_sub);
        }
    }
    SEAM(4);
    if (IN(5)) {
        pg8::Gemm g{OAB, WUP, DM, DM, 512, 512, 512}; pg8::StaticOrder S; S.init(M, DM, G, (int)blockIdx.x, 2);
        pg8::EpiUp E{QKV, Yb};
        pg8::gemm_phase(lds, g, S, E);
    }
    SEAM(5);
    if (IN(6)) {
        pg8::Gemm g{Yb, WOUT, DM, DM, DM, 0, 0}; pg8::StaticOrder S; S.init(M, DM, G, (int)blockIdx.x, 1);
        pg8::EpiResid<true> E{XB, XB, SS2, 1.0f};
        pg8::gemm_phase(lds, g, S, E);
    }
    SEAM(6);
    if (IN(7)) {
        pg8::Gemm g{XB, WGU2, DM, DM, DM, 0, 0}; pg8::StaticOrder S; S.init(M, 2 * FF, G, (int)blockIdx.x, 1);
        pg8::EpiSwiglu<16> E{Hb, SS2};
        pg8::gemm_phase(lds, g, S, E);
    }
    SEAM(7);
    if (IN(8)) {
        pg8::Gemm g{Hb, WD2, FF, FF, FF, 0, 0}; pg8::StaticOrder S; S.init(M, DM, G, (int)blockIdx.x, 1);
        pg8::EpiResid<true> E{XB, XB, SS3, 0.5f};
        pg8::gemm_phase(lds, g, S, E);
    }
    SEAM(8);
    if (IN(9)) {
        const f32x4* gr = (const f32x4*)g_final + lane;
        f32x4 gg[4];
#pragma unroll
        for (int j = 0; j < 4; ++j) gg[j] = gr[64 * j];
        for (int m0 = gw * 4; m0 < M; m0 += NGW * 4) {
            float sp[4]; u32x2 w[4][4];
#pragma unroll
            for (int q = 0; q < 4; ++q) { sp[q] = SS3[(size_t)(lane & 15) * M + m0 + q]; const u32x2* xr = (const u32x2*)(XB + (size_t)(m0 + q) * DM) + lane;
#pragma unroll
                for (int j = 0; j < 4; ++j) w[q][j] = xr[64 * j]; }
#pragma unroll
            for (int q = 0; q < 4; ++q) { float sv = sp[q];
                sv += __shfl_xor(sv, 1); sv += __shfl_xor(sv, 2); sv += __shfl_xor(sv, 4); sv += __shfl_xor(sv, 8);
                const float rs = rsqrtf(sv * (1.0f / DM) + EPS);
                f32x4* orow = (f32x4*)(out + (size_t)(m0 + q) * DM) + lane;
#pragma unroll
                for (int j = 0; j < 4; ++j) { f32x4 o; o[0] = bflo(w[q][j].x) * rs * gg[j][0]; o[1] = bfhi(w[q][j].x) * rs * gg[j][1]; o[2] = bflo(w[q][j].y) * rs * gg[j][2]; o[3] = bfhi(w[q][j].y) * rs * gg[j][3]; orow[64 * j] = o; } }
        }
    }
#undef IN
#undef SEAM
}

extern "C" void kernel_launch(void* const* d_in, const int* in_sizes, int n_in, void* d_out, int out_size, void* d_ws, size_t ws_size, hipStream_t stream) {
    static int grid = 0;
    if (grid == 0) {
        if (n_in != 23 || in_sizes[0] != M * DM || out_size != M * DM || ws_size < WS_END) {
            fprintf(stderr, "kernel_launch: unexpected shapes (n_in %d, in0 %d, out %d, ws %zu need %zu)\n", n_in, n_in > 0 ? in_sizes[0] : -1, out_size, ws_size, (size_t)WS_END); grid = -1; return; }
        int dev = 0, cus = 0, per_cu = 0;
        hipGetDevice(&dev); hipDeviceGetAttribute(&cus, hipDeviceAttributeMultiprocessorCount, dev);
        hipFuncSetAttribute((const void*)fwd_kernel, hipFuncAttributeMaxDynamicSharedMemorySize, LDS_BYTES);
        hipOccupancyMaxActiveBlocksPerMultiprocessor(&per_cu, (const void*)fwd_kernel, NWAVES * 64, LDS_BYTES);
        if (per_cu < 1) { fprintf(stderr, "kernel_launch: occupancy query says %d blocks/CU\n", per_cu); per_cu = 1; }
        (void)hipGetLastError();
        grid = cus * per_cu;
    }
    if (grid < 0) return;
    Args a{};
    for (int i = 0; i < 23; ++i) a.in[i] = (const float*)d_in[i];
    a.out = (float*)d_out; a.ws = (unsigned char*)d_ws;
    if (MK_N_LAUNCHES == 1) {
        hipMemsetAsync((unsigned char*)d_ws + OFF_BAR, 0, BAR_BYTES, stream);
        a.ph_lo = 0; a.ph_hi = N_PHASES;
        void* kargs[] = {&a};
        hipError_t e = hipLaunchCooperativeKernel((const void*)fwd_kernel, dim3(grid), dim3(NWAVES * 64), kargs, LDS_BYTES, stream);
        if (e != hipSuccess) fprintf(stderr, "cooperative launch failed: %s (grid %d)\n", hipGetErrorString(e), grid);
    } else {
        for (int p = 0; p < N_PHASES; ++p) { a.ph_lo = p; a.ph_hi = p + 1; for (int rep = 0; rep < (p == PROBE_REP_PHASE ? 2 : 1); ++rep) hipLaunchKernelGGL(fwd_kernel, dim3(grid), dim3(NWAVES * 64), LDS_BYTES, stream, a); }
    }
}
```

```cpp
#include <hip/hip_runtime.h>
#include <hip/hip_cooperative_groups.h>
#include <cstdio>
#include <cstdint>
namespace cg = cooperative_groups;

#ifndef MK_N_LAUNCHES
#define MK_N_LAUNCHES 1
#endif
#ifndef PROBE_REP_PHASE
#define PROBE_REP_PHASE -1
#endif

#define LAS __attribute__((address_space(3)))
typedef unsigned short bf16_t;
typedef short bf16x8 __attribute__((ext_vector_type(8)));
typedef short s16x4 __attribute__((ext_vector_type(4)));
typedef float f32x4 __attribute__((ext_vector_type(4)));
typedef float f32x16 __attribute__((ext_vector_type(16)));
typedef unsigned u32x4 __attribute__((ext_vector_type(4)));
typedef unsigned u32x2 __attribute__((ext_vector_type(2)));
typedef float f32x2_t __attribute__((ext_vector_type(2)));
typedef __bf16 bf16x2_t __attribute__((ext_vector_type(2)));

constexpr int M = 32768, DM = 1024, FF = 2816, NIN = 5120, SEQ = 4096;
constexpr float EPS = 1e-6f;
constexpr float LOG2E = 1.4426950408889634f;
constexpr float QSCALE = 0.125f * LOG2E;

__device__ __forceinline__ unsigned cvtpk(float lo, float hi) { f32x2_t v = {lo, hi}; bf16x2_t b = __builtin_convertvector(v, bf16x2_t); return __builtin_bit_cast(unsigned, b); }
__device__ __forceinline__ float bflo(unsigned u) { return __uint_as_float(u << 16); }
__device__ __forceinline__ float bfhi(unsigned u) { return __uint_as_float(u & 0xffff0000u); }
__device__ __forceinline__ float wave_sum(float v) {
#pragma unroll
    for (int o = 1; o < 64; o <<= 1) v += __shfl_xor(v, o);
    return v;
}
__device__ __forceinline__ float sum_x16(float v) { auto rr = __builtin_amdgcn_permlane16_swap(__float_as_uint(v), __float_as_uint(v), false, false); return __uint_as_float(rr[0]) + __uint_as_float(rr[1]); }
__device__ __forceinline__ float sum_x32(float v) { auto rr = __builtin_amdgcn_permlane32_swap(__float_as_uint(v), __float_as_uint(v), false, false); return __uint_as_float(rr[0]) + __uint_as_float(rr[1]); }
__device__ __forceinline__ float get_x16(float v, int oddrow) { auto rr = __builtin_amdgcn_permlane16_swap(__float_as_uint(v), __float_as_uint(v), false, false); return __uint_as_float(oddrow ? rr[0] : rr[1]); }
__device__ __forceinline__ float fast_exp2(float x) { return __builtin_amdgcn_exp2f(x); }
__device__ __forceinline__ float fast_rcp(float x) { return __builtin_amdgcn_rcpf(x); }
__device__ __forceinline__ float sigmoidf_(float x) { return fast_rcp(1.0f + fast_exp2(-x * LOG2E)); }

template <int NP>
__device__ __forceinline__ float row_rs(const float* ss, int row) {
    float v[NP];
#pragma unroll
    for (int p = 0; p < NP; ++p) v[p] = ss[(size_t)p * M + row];
    float s = 0.f;
#pragma unroll
    for (int p = 0; p < NP; ++p) s += v[p];
    return rsqrtf(s * (1.0f / DM) + EPS);
}

constexpr int LDS_RS = 131072;
template <int NP>
__device__ __forceinline__ void rs_prep(LAS unsigned char* lds, const float* ss, int pm, int ui) {
    const int t = threadIdx.x;
    if (t < 256) ((LAS float*)(lds + LDS_RS + (ui & 1) * 1024))[t] = row_rs<NP>(ss, pm * 256 + t);
}
__device__ __forceinline__ float rs_get(LAS unsigned char* lds, int ui, int lrow) { return ((LAS float*)(lds + LDS_RS + (ui & 1) * 1024))[lrow]; }

namespace pg8 {
constexpr int BM = 256, BK = 64, HALF = 128, HTB = HALF * BK * 2, STAGE_BYTES = 8 * HTB, NXCD = 8, WGM = 8;
__host__ __device__ __forceinline__ int lds_byte(int r, int c) { const int st = (r >> 4) * 2 + (c >> 5), rr = r & 15, cc = c & 31, ob = rr * 64 + cc * 2; return st * 1024 + (ob ^ (((ob >> 9) & 1) << 5)); }
__host__ __device__ __forceinline__ void stage_rc(int b, int& R, int& C) { const int st = b / 1024, sb = b % 1024, swz = sb ^ (((sb >> 9) & 1) << 5); R = (st >> 1) * 16 + swz / 64; C = (st & 1) * 32 + (swz % 64) / 2; }
__host__ __device__ __forceinline__ int perm32(int rho) { const int n = rho >> 4, i = rho & 15; return 8 * (i >> 2) + 4 * n + (i & 3); }

struct Unit { int pm, pn, kh; };
struct Gemm { const bf16_t* A; const bf16_t* Bt; int lda, ldb, K, akh, bkh; };

struct StaticOrder {
    int nM, nN, nwg, G, c, KH;
    __device__ void init(int Mr, int N, int G_, int c_, int KH_) { nM = Mr / BM; nN = N / BM; nwg = nM * nN; G = G_; c = c_; KH = KH_; }
    __device__ bool next(int i, Unit& u) const {
        const int it = (KH == 2) ? (i >> 1) : i; u.kh = (KH == 2) ? (i & 1) : 0;
        const long L = (long)it * G + c; if (L >= nwg) return false;
        int wgid = (int)L; { const int q = nwg / NXCD, r = nwg % NXCD, xcd = wgid % NXCD, off = wgid / NXCD; wgid = (xcd < r ? xcd * (q + 1) : r * (q + 1) + (xcd - r) * q) + off; }
        const int nig = WGM * nN, gid = wgid / nig, fm = gid * WGM, gsz = (nM - fm) < WGM ? (nM - fm) : WGM;
        u.pm = fm + ((wgid % nig) % gsz); u.pn = (wgid % nig) / gsz; return true;
    }
};

template <class Epi, class Sched>
__device__ __forceinline__ void gemm_phase(LAS unsigned char* lds, const Gemm g, const Sched& S, const Epi& E) {
    const int tid = threadIdx.x, wid = __builtin_amdgcn_readfirstlane(tid >> 6), lane = tid & 63, wr = wid >> 2, wc = wid & 3, fr = lane & 15, fq = lane >> 4;
    const int nt = g.K / BK;
    unsigned voffA[2], voffB[2];
#pragma unroll
    for (int i = 0; i < 2; ++i) { int R, C; stage_rc(tid * 16 + i * 8192, R, C); const int Rb = (R & ~31) + perm32(R & 31);
        voffA[i] = (unsigned)(R * g.lda + C) * 2u; voffB[i] = (unsigned)(Rb * g.ldb + C) * 2u; }
    const size_t kstep = (size_t)(BK * 2);
    const size_t hstepA = (size_t)HALF * g.lda * 2, hstepB = (size_t)HALF * g.ldb * 2;
    const size_t tstepA = 2 * hstepA, tstepB = 2 * hstepB;
    const unsigned ldsw = (unsigned)wid * 1024u;
    const int aoff = lds_byte(wr * 64 + fr, fq * 8), boff = lds_byte(wc * 32 + fr, fq * 8);
#define PG8_SA(b, h) (((b) * 2 + (h)) * HTB)
#define PG8_SB(b, h) ((4 + (b) * 2 + (h)) * HTB)
#define PG8_STAGE(bufoff, gbase, voff) do { _Pragma("unroll") for (int _i = 0; _i < 2; ++_i) \
        __builtin_amdgcn_global_load_lds((const unsigned*)((const char*)(gbase) + (voff)[_i]), (LAS unsigned*)(lds + (bufoff) + ldsw + _i * 8192), 16, 0, 0); } while (0)
#define PG8_LDA(dst, b, h) do { _Pragma("unroll") for (int m = 0; m < 4; ++m) _Pragma("unroll") for (int k = 0; k < 2; ++k) dst[m][k] = *(const LAS bf16x8*)(lds + PG8_SA(b, h) + aoff + m * 2048 + k * 1024); } while (0)
#define PG8_LDB(dst, b, h) do { _Pragma("unroll") for (int n = 0; n < 2; ++n) _Pragma("unroll") for (int k = 0; k < 2; ++k) dst[n][k] = *(const LAS bf16x8*)(lds + PG8_SB(b, h) + boff + n * 2048 + k * 1024); } while (0)
#define PG8_MMA(ai, bj, At, Bt) do { __builtin_amdgcn_s_setprio(1); _Pragma("unroll") for (int m = 0; m < 4; ++m) _Pragma("unroll") for (int n = 0; n < 2; ++n) _Pragma("unroll") for (int k = 0; k < 2; ++k) \
        acc[ai][bj][m][n] = __builtin_amdgcn_mfma_f32_16x16x32_bf16(Bt[n][k], At[m][k], acc[ai][bj][m][n], 0, 0, 0); __builtin_amdgcn_s_setprio(0); } while (0)
#define PG8_WAIT_V(n) asm volatile("s_waitcnt vmcnt(" #n ")" ::: "memory")
#define PG8_WAIT_L(n) asm volatile("s_waitcnt lgkmcnt(" #n ")" ::: "memory")
#define PG8_BAR __builtin_amdgcn_s_barrier()
#define PG8_SCHED __builtin_amdgcn_sched_barrier(0)
#define PG8_UA(u) ((const char*)g.A + (size_t)(u).pm * tstepA + (size_t)((u).kh * g.akh) * 2)
#define PG8_UB(u) ((const char*)g.Bt + (size_t)(u).pn * tstepB + (size_t)((u).kh * g.bkh) * 2)
    Unit cur, nxt; int ui = 0;
    if (!S.next(0, cur)) return;
    f32x4 acc[2][2][4][2];
#pragma unroll
    for (int a = 0; a < 2; ++a)
#pragma unroll
        for (int b = 0; b < 2; ++b)
#pragma unroll
            for (int m = 0; m < 4; ++m)
#pragma unroll
                for (int n = 0; n < 2; ++n) acc[a][b][m][n] = (f32x4){0.f, 0.f, 0.f, 0.f};
    bf16x8 At[4][2], B0[2][2], B1[2][2];
    const char* cA = PG8_UA(cur); const char* cB = PG8_UB(cur);
    E.prep(lds, cur, 0);
    PG8_STAGE(PG8_SB(0, 0), cB, voffB); PG8_STAGE(PG8_SB(0, 1), cB + hstepB, voffB); PG8_STAGE(PG8_SA(0, 0), cA, voffA); PG8_STAGE(PG8_SA(0, 1), cA + hstepA, voffA);
    if (wr == 1) PG8_BAR;
    PG8_WAIT_V(2); PG8_BAR;
    PG8_STAGE(PG8_SB(1, 0), cB + kstep, voffB); PG8_STAGE(PG8_SA(1, 0), cA + kstep, voffA); PG8_STAGE(PG8_SB(1, 1), cB + hstepB + kstep, voffB);
    PG8_WAIT_V(6); PG8_BAR;
    for (;;) {
        const bool has_next = S.next(ui + 1, nxt);
        const char* nA = has_next ? PG8_UA(nxt) : cA; const char* nB = has_next ? PG8_UB(nxt) : cB;
        for (int t = 0; t < nt; t += 2) {
            const bool last = (t == nt - 2);
            const char* a1 = cA + (size_t)(t + 1) * kstep;
            const char* a2 = last ? nA : cA + (size_t)(t + 2) * kstep; const char* b2 = last ? nB : cB + (size_t)(t + 2) * kstep;
            const char* a3 = a2 + kstep; const char* b3 = b2 + kstep;
            PG8_LDB(B0, 0, 0); PG8_LDB(B1, 0, 1); PG8_SCHED; PG8_LDA(At, 0, 0); PG8_STAGE(PG8_SA(1, 1), a1 + hstepA, voffA);
            PG8_WAIT_V(8); PG8_WAIT_L(0); PG8_BAR; PG8_MMA(0, 0, At, B0); PG8_MMA(0, 1, At, B1); PG8_BAR; PG8_SCHED;
            PG8_LDA(At, 0, 1); PG8_STAGE(PG8_SB(0, 0), b2, voffB); PG8_STAGE(PG8_SB(0, 1), b2 + hstepB, voffB); PG8_STAGE(PG8_SA(0, 0), a2, voffA);
            PG8_WAIT_V(8); PG8_WAIT_L(0); PG8_BAR; PG8_MMA(1, 0, At, B0); PG8_MMA(1, 1, At, B1); PG8_BAR; PG8_SCHED;
            PG8_LDB(B0, 1, 0); PG8_LDB(B1, 1, 1); PG8_SCHED; PG8_LDA(At, 1, 0); PG8_STAGE(PG8_SA(0, 1), a2 + hstepA, voffA);
            PG8_WAIT_V(8); PG8_WAIT_L(0); PG8_BAR; PG8_MMA(0, 0, At, B0); PG8_MMA(0, 1, At, B1); PG8_BAR; PG8_SCHED;
            PG8_LDA(At, 1, 1); PG8_STAGE(PG8_SB(1, 0), b3, voffB); PG8_STAGE(PG8_SB(1, 1), b3 + hstepB, voffB); PG8_STAGE(PG8_SA(1, 0), a3, voffA);
            PG8_WAIT_V(8); PG8_WAIT_L(0); PG8_BAR; PG8_MMA(1, 0, At, B0); PG8_MMA(1, 1, At, B1); PG8_BAR; PG8_SCHED;
        }
        if (wr == 0) PG8_BAR;
        E(acc, cur, wr, wc, fr, fq, lds, ui);
        if (!has_next) break;
        if (!(Epi::KEEP && cur.kh == 0)) {
#pragma unroll
            for (int a = 0; a < 2; ++a)
#pragma unroll
                for (int b = 0; b < 2; ++b)
#pragma unroll
                    for (int m = 0; m < 4; ++m)
#pragma unroll
                        for (int n = 0; n < 2; ++n) acc[a][b][m][n] = (f32x4){0.f, 0.f, 0.f, 0.f};
        }
        cur = nxt; cA = nA; cB = nB; ++ui;
        E.prep(lds, cur, ui);
        if (wr == 1) PG8_BAR;
    }
    PG8_WAIT_V(0);
    PG8_BAR;
#undef PG8_SA
#undef PG8_SB
#undef PG8_STAGE
#undef PG8_LDA
#undef PG8_LDB
#undef PG8_MMA
#undef PG8_WAIT_V
#undef PG8_WAIT_L
#undef PG8_BAR
#undef PG8_SCHED
#undef PG8_UA
#undef PG8_UB
}

template <int NP> struct EpiSwiglu {
    static constexpr bool KEEP = false;
    bf16_t* H; const float* ss;
    __device__ __forceinline__ void prep(LAS unsigned char* lds, const Unit& u, int ui) const { rs_prep<NP>(lds, ss, u.pm, ui); }
    __device__ __forceinline__ void operator()(f32x4 (&acc)[2][2][4][2], const Unit& u, int wr, int wc, int fr, int fq, LAS unsigned char* lds, int ui) const {
        const int row0 = u.pm * BM + wr * 64 + fr, col0 = u.pn * 128 + wc * 32 + 8 * fq;
#pragma unroll
        for (int ai = 0; ai < 2; ++ai)
#pragma unroll
            for (int m = 0; m < 4; ++m) {
                const int row = row0 + ai * HALF + m * 16; const float r = rs_get(lds, ui, ai * HALF + wr * 64 + m * 16 + fr);
                float hv[8];
#pragma unroll
                for (int n = 0; n < 2; ++n)
#pragma unroll
                    for (int e = 0; e < 4; ++e) { const float gg = acc[ai][0][m][n][e] * r, uu = acc[ai][1][m][n][e] * r; hv[n * 4 + e] = gg * uu * sigmoidf_(gg); }
                u32x4 w; w.x = cvtpk(hv[0], hv[1]); w.y = cvtpk(hv[2], hv[3]); w.z = cvtpk(hv[4], hv[5]); w.w = cvtpk(hv[6], hv[7]);
                *(u32x4*)(H + (size_t)row * FF + col0) = w;
            }
    }
};
template <bool SRC_BF16> struct EpiResid {
    static constexpr bool KEEP = false;
    const void* src; bf16_t* xb; float* ssout; float alpha;
    __device__ __forceinline__ void prep(LAS unsigned char*, const Unit&, int) const {}
    __device__ __forceinline__ void operator()(f32x4 (&acc)[2][2][4][2], const Unit& u, int wr, int wc, int fr, int fq, LAS unsigned char*, int) const {
        const int row0 = u.pm * BM + wr * 64 + fr, col0 = u.pn * BM + wc * 32 + 8 * fq;
#pragma unroll
        for (int ai = 0; ai < 2; ++ai)
#pragma unroll
            for (int m = 0; m < 4; ++m) {
                const int row = row0 + ai * HALF + m * 16; float sq = 0.f;
#pragma unroll
                for (int bj = 0; bj < 2; ++bj) {
                    const size_t off = (size_t)row * DM + col0 + bj * HALF;
                    f32x4 a, b;
                    if (SRC_BF16) { const u32x4 w = *(const u32x4*)((const bf16_t*)src + off);
                        a = (f32x4){bflo(w.x), bfhi(w.x), bflo(w.y), bfhi(w.y)}; b = (f32x4){bflo(w.z), bfhi(w.z), bflo(w.w), bfhi(w.w)}; }
                    else { a = *(const f32x4*)((const float*)src + off); b = *(const f32x4*)((const float*)src + off + 4); }
                    const f32x4 o0 = a + acc[ai][bj][m][0] * alpha, o1 = b + acc[ai][bj][m][1] * alpha;
                    sq += (o0[0] * o0[0] + o0[1] * o0[1]) + (o0[2] * o0[2] + o0[3] * o0[3]) + (o1[0] * o1[0] + o1[1] * o1[1]) + (o1[2] * o1[2] + o1[3] * o1[3]);
                    u32x4 w; w.x = cvtpk(o0[0], o0[1]); w.y = cvtpk(o0[2], o0[3]); w.z = cvtpk(o1[0], o1[1]); w.w = cvtpk(o1[2], o1[3]); *(u32x4*)(xb + off) = w;
                }
                sq = sum_x32(sum_x16(sq));
                if (fq == 0) ssout[(size_t)(u.pn * 4 + wc) * M + row] = sq;
                if (m == 3) asm volatile("" ::: "memory");
            }
    }
};
template <int NP> struct EpiWin {
    static constexpr bool KEEP = false;
    bf16_t* QKV; const float* ss; const float *qn_a, *kn_a, *qn_b, *kn_b; const float* rope;
    __device__ __forceinline__ void prep(LAS unsigned char* lds, const Unit& u, int ui) const { rs_prep<NP>(lds, ss, u.pm, ui); }
    __device__ __forceinline__ void operator()(f32x4 (&acc)[2][2][4][2], const Unit& u, int wr, int wc, int fr, int fq, LAS unsigned char* lds, int ui) const {
        const int pn = u.pn; int type; const float* gain = qn_a; float qs = 1.0f;
        if (pn < 2) { type = 0; gain = qn_a; qs = QSCALE; } else if (pn < 4) { type = 0; gain = kn_a; } else if (pn < 6) { type = 2; }
        else if (pn < 8) { type = 1; gain = qn_b; qs = QSCALE; } else if (pn < 10) { type = 1; gain = kn_b; } else if (pn < 12) { type = 2; } else { type = 3; }
        f32x4 gv[2][2];
#pragma unroll
        for (int bj = 0; bj < 2; ++bj)
#pragma unroll
            for (int n = 0; n < 2; ++n) gv[bj][n] = *(const f32x4*)(gain + bj * 32 + 8 * fq + 4 * n);
        const int row0 = u.pm * BM + wr * 64 + fr, colb = pn * 256 + wc * 64 + 8 * fq;
#pragma unroll
        for (int ai = 0; ai < 2; ++ai)
#pragma unroll
            for (int m = 0; m < 4; ++m) {
                const int row = row0 + ai * HALF + m * 16; const float r = rs_get(lds, ui, ai * HALF + wr * 64 + m * 16 + fr);
                f32x4 v[2][2];
#pragma unroll
                for (int bj = 0; bj < 2; ++bj)
#pragma unroll
                    for (int n = 0; n < 2; ++n) v[bj][n] = acc[ai][bj][m][n] * r;
                if (type <= 1) {
                    float sq = 0.f;
#pragma unroll
                    for (int bj = 0; bj < 2; ++bj)
#pragma unroll
                        for (int n = 0; n < 2; ++n) sq += (v[bj][n][0] * v[bj][n][0] + v[bj][n][1] * v[bj][n][1]) + (v[bj][n][2] * v[bj][n][2] + v[bj][n][3] * v[bj][n][3]);
                    sq = sum_x32(sum_x16(sq));
                    const float hn = rsqrtf(sq * (1.0f / 64.0f) + EPS);
#pragma unroll
                    for (int bj = 0; bj < 2; ++bj)
#pragma unroll
                        for (int n = 0; n < 2; ++n) v[bj][n] = v[bj][n] * hn * gv[bj][n];
                    if (type == 1) {
                        const float* cs = rope + (size_t)(row & (SEQ - 1)) * 16;
#pragma unroll
                        for (int n = 0; n < 2; ++n) {
                            const f32x4 c0 = *(const f32x4*)(cs + n * 8), c1 = *(const f32x4*)(cs + n * 8 + 4);
                            f32x4 pr;
#pragma unroll
                            for (int e = 0; e < 4; ++e) pr[e] = get_x16(v[0][n][e], fq & 1);
                            const float sg = (fq == 0) ? -1.0f : 1.0f;
                            f32x4 o;
                            o[0] = v[0][n][0] * c0[0] + sg * pr[0] * c0[1]; o[1] = v[0][n][1] * c0[2] + sg * pr[1] * c0[3];
                            o[2] = v[0][n][2] * c1[0] + sg * pr[2] * c1[1]; o[3] = v[0][n][3] * c1[2] + sg * pr[3] * c1[3];
                            if (fq < 2) v[0][n] = o;
                        }
                    }
#pragma unroll
                    for (int bj = 0; bj < 2; ++bj)
#pragma unroll
                        for (int n = 0; n < 2; ++n) v[bj][n] = v[bj][n] * qs;
                } else if (type == 3) {
#pragma unroll
                    for (int n = 0; n < 2; ++n)
#pragma unroll
                        for (int e = 0; e < 4; ++e) { const float ea = 1.0f + fast_exp2(-v[0][n][e] * LOG2E), eb = 1.0f + fast_exp2(-v[1][n][e] * LOG2E);
                            v[0][n][e] = eb * fast_rcp(ea); v[1][n][e] = fast_rcp(eb); }
                }
#pragma unroll
                for (int bj = 0; bj < 2; ++bj) {
                    u32x4 w; w.x = cvtpk(v[bj][0][0], v[bj][0][1]); w.y = cvtpk(v[bj][0][2], v[bj][0][3]); w.z = cvtpk(v[bj][1][0], v[bj][1][1]); w.w = cvtpk(v[bj][1][2], v[bj][1][3]);
                    *(u32x4*)(QKV + (size_t)row * NIN + (type == 3 ? 3072 + bj * 1024 + (pn - 12) * 128 + wc * 32 + 8 * fq : colb + bj * 32)) = w;
                }
                if (m & 1) asm volatile("" ::: "memory");
            }
    }
};
struct EpiUp {
    static constexpr bool KEEP = true;
    const bf16_t* QKV; bf16_t* Y;
    __device__ __forceinline__ void prep(LAS unsigned char*, const Unit&, int) const {}
    __device__ __forceinline__ void operator()(f32x4 (&acc)[2][2][4][2], const Unit& u, int wr, int wc, int fr, int fq, LAS unsigned char*, int) const {
        const int row0 = u.pm * BM + wr * 64 + fr, col0 = u.pn * BM + wc * 32 + 8 * fq;
#pragma unroll
        for (int ai = 0; ai < 2; ++ai)
#pragma unroll
            for (int m = 0; m < 4; ++m) {
                const int row = row0 + ai * HALF + m * 16;
#pragma unroll
                for (int bj = 0; bj < 2; ++bj) {
                    const int c = col0 + bj * HALF;
                    const u32x4 sb = *(const u32x4*)(QKV + (size_t)row * NIN + (u.kh == 0 ? 3072 : 4096) + c);
                    float fb[8] = {bflo(sb.x), bfhi(sb.x), bflo(sb.y), bfhi(sb.y), bflo(sb.z), bfhi(sb.z), bflo(sb.w), bfhi(sb.w)};
                    if (u.kh == 0) {
#pragma unroll
                        for (int n = 0; n < 2; ++n)
#pragma unroll
                            for (int e = 0; e < 4; ++e) acc[ai][bj][m][n][e] *= fb[n * 4 + e];
                    } else {
                        float y[8];
#pragma unroll
                        for (int n = 0; n < 2; ++n)
#pragma unroll
                            for (int e = 0; e < 4; ++e) y[n * 4 + e] = acc[ai][bj][m][n][e] * fb[n * 4 + e];
                        u32x4 w; w.x = cvtpk(y[0], y[1]); w.y = cvtpk(y[2], y[3]); w.z = cvtpk(y[4], y[5]); w.w = cvtpk(y[6], y[7]);
                        *(u32x4*)(Y + (size_t)row * DM + c) = w;
                    }
                }
                if (m == 3) asm volatile("" ::: "memory");
            }
    }
};
}

namespace att {
template <int KIND> struct AK;
template <> struct AK<0> { static constexpr int DVB = 2, ROWB = 128, KP = 144, VP = 192, NLD = 1; };
template <> struct AK<1> { static constexpr int DVB = 4, ROWB = 256, KP = 272, VP = 320, NLD = 2; };
constexpr int AL_K = 0, AL_V = 34816, AL_X = 0, AL_T = 96256;
typedef short v4i16_t __attribute__((ext_vector_type(4)));
__device__ __forceinline__ s16x4 vtr(const LAS unsigned char* p) { return __builtin_bit_cast(s16x4, __builtin_amdgcn_ds_read_tr16_b64_v4i16((LAS v4i16_t*)p)); }
__device__ __forceinline__ constexpr int cr(int i) { return (i & 3) + 8 * (i >> 2); }

__device__ __forceinline__ float max3f(float a, float b, float c) { float r; asm("v_max3_f32 %0, %1, %2, %3" : "=v"(r) : "v"(a), "v"(b), "v"(c)); return r; }

template <int DVB, int KP>
__device__ __forceinline__ void qk_softmax(const LAS unsigned char* Kl, const bf16x8 (&qf)[4], f32x16 (&O)[DVB], float& mrun, float& lrun, bf16x8 (&pk)[4],
                                           bool first, int lane, int biasmode, const LAS float* tb, float cbias) {
    const int r = lane & 31, h = lane >> 5;
    const LAS unsigned char* kp = Kl + r * KP + h * 16;
    f32x16 p0, p1, zero16;
#pragma unroll
    for (int i = 0; i < 16; ++i) zero16[i] = 0.f;
#pragma unroll
    for (int ks = 0; ks < 4; ++ks) {
        const bf16x8 a0 = *(const LAS bf16x8*)(kp + ks * 32), a1 = *(const LAS bf16x8*)(kp + 32 * KP + ks * 32);
        if (ks == 0) { p0 = __builtin_amdgcn_mfma_f32_32x32x16_bf16(a0, qf[0], zero16, 0, 0, 0); p1 = __builtin_amdgcn_mfma_f32_32x32x16_bf16(a1, qf[0], zero16, 0, 0, 0); }
        else { p0 = __builtin_amdgcn_mfma_f32_32x32x16_bf16(a0, qf[ks], p0, 0, 0, 0); p1 = __builtin_amdgcn_mfma_f32_32x32x16_bf16(a1, qf[ks], p1, 0, 0, 0); }
    }
    if (biasmode == 1) {
#pragma unroll
        for (int i = 0; i < 16; ++i) { p0[i] += tb[-cr(i)]; p1[i] += tb[-32 - cr(i)]; }
    } else if (biasmode == 2) {
#pragma unroll
        for (int i = 0; i < 16; ++i) { p0[i] += cbias; p1[i] += cbias; }
    }
    asm volatile("s_nop 15\n\ts_nop 7" : "+v"(p0), "+v"(p1));
    float ta = max3f(p0[0], p0[1], p1[0]), tbm = max3f(p0[2], p0[3], p1[1]); ta = max3f(ta, p1[2], p1[3]);
#pragma unroll
    for (int i = 4; i < 16; i += 4) { ta = max3f(ta, p0[i], p0[i + 1]); tbm = max3f(tbm, p0[i + 2], p0[i + 3]); ta = max3f(ta, p1[i], p1[i + 1]); tbm = max3f(tbm, p1[i + 2], p1[i + 3]); }
    float tm = max3f(ta, tbm, tbm);
    { auto rr = __builtin_amdgcn_permlane32_swap(__float_as_uint(tm), __float_as_uint(tm), false, false); tm = max3f(__uint_as_float(rr[0]), __uint_as_float(rr[1]), tm); }
    if (first || (__builtin_amdgcn_ballot_w64(tm > mrun + 8.0f) != 0ull)) {
        const float mnew = first ? tm : fmaxf(mrun, tm);
        if (!first) { const float alpha = fast_exp2(mrun - mnew);
#pragma unroll
            for (int d = 0; d < DVB; ++d)
#pragma unroll
                for (int i = 0; i < 16; ++i) O[d][i] *= alpha;
            lrun *= alpha; }
        mrun = mnew;
    }
    float s0 = 0.f, s1 = 0.f;
#pragma unroll
    for (int i = 0; i < 16; ++i) { p0[i] = fast_exp2(p0[i] - mrun); p1[i] = fast_exp2(p1[i] - mrun); s0 += p0[i]; s1 += p1[i]; }
    lrun += s0 + s1;
    { u32x4 w;
      w.x = cvtpk(p0[0], p0[1]); w.y = cvtpk(p0[2], p0[3]); w.z = cvtpk(p0[4], p0[5]); w.w = cvtpk(p0[6], p0[7]); pk[0] = __builtin_bit_cast(bf16x8, w);
      w.x = cvtpk(p0[8], p0[9]); w.y = cvtpk(p0[10], p0[11]); w.z = cvtpk(p0[12], p0[13]); w.w = cvtpk(p0[14], p0[15]); pk[1] = __builtin_bit_cast(bf16x8, w);
      w.x = cvtpk(p1[0], p1[1]); w.y = cvtpk(p1[2], p1[3]); w.z = cvtpk(p1[4], p1[5]); w.w = cvtpk(p1[6], p1[7]); pk[2] = __builtin_bit_cast(bf16x8, w);
      w.x = cvtpk(p1[8], p1[9]); w.y = cvtpk(p1[10], p1[11]); w.z = cvtpk(p1[12], p1[13]); w.w = cvtpk(p1[14], p1[15]); pk[3] = __builtin_bit_cast(bf16x8, w); }
}
template <int DVB, int VP>
__device__ __forceinline__ void pv_tile(const LAS unsigned char* Vl, const bf16x8 (&pk)[4], f32x16 (&O)[DVB], int lane) {
    const int g = lane >> 4, i16 = lane & 15, q = i16 >> 2, pp = i16 & 3;
    const LAS unsigned char* vp = Vl + (4 * (g >> 1) + q) * VP + (16 * (g & 1) + 4 * pp) * 2;
    s16x4 lo[2][DVB], hi[2][DVB];
#pragma unroll
    for (int d = 0; d < DVB; ++d) { lo[0][d] = vtr(vp + d * 64); hi[0][d] = vtr(vp + 8 * VP + d * 64); }
#pragma unroll
    for (int f = 0; f < 4; ++f) {
        if (f < 3) { const int key0 = 32 * ((f + 1) >> 1) + 16 * ((f + 1) & 1);
#pragma unroll
            for (int d = 0; d < DVB; ++d) { lo[(f + 1) & 1][d] = vtr(vp + key0 * VP + d * 64); hi[(f + 1) & 1][d] = vtr(vp + (key0 + 8) * VP + d * 64); } }
#pragma unroll
        for (int d = 0; d < DVB; ++d) {
            const bf16x8 vf = __builtin_shufflevector(lo[f & 1][d], hi[f & 1][d], 0, 1, 2, 3, 4, 5, 6, 7);
            O[d] = __builtin_amdgcn_mfma_f32_32x32x16_bf16(vf, pk[f], O[d], 0, 0, 0);
        }
        __builtin_amdgcn_sched_barrier(0);
    }
}

template <int KIND>
__device__ __forceinline__ void attn_unit(LAS unsigned char* lds, const bf16_t* QKV, bf16_t* OUT, int b, int hd, int blk, const float* relb, float lam, const float* gsub) {
    using P = AK<KIND>;
    constexpr int DVB = P::DVB, KP = P::KP, VP = P::VP, NLD = P::NLD, CPR = P::ROWB / 16;
    const int tid = threadIdx.x, lane = tid & 63, wid = __builtin_amdgcn_readfirstlane(tid >> 6), r = lane & 31, h = lane >> 5;
    int qbase, qc, tlo, thi, klo, comp = 0, rg = 0, qcol, kcol, vcol, ocol;
    if (KIND == 0) { const int c0 = blk * 4; qc = c0 + (wid >> 1); qbase = qc * 64 + (wid & 1) * 32; tlo = c0 - 8 < 0 ? 0 : c0 - 8; thi = c0 + 3; klo = qc - 8;
        qcol = hd * 64; kcol = 512 + hd * 64; vcol = 1024 + hd * 64; ocol = hd * 64; }
    else { comp = wid >> 2; rg = wid & 3; qbase = blk * 128 + rg * 32; qc = qbase >> 6; tlo = 0; thi = 2 * blk + 1; klo = 0;
        qcol = 1536 + (2 * hd + comp) * 64; kcol = 2048 + hd * 128; vcol = 2560 + hd * 128; ocol = 512 + hd * 128; }
    if (klo < tlo) klo = tlo;
    const bool skew = wid >= 4;
    const size_t tok0 = (size_t)b * SEQ;
    LAS float* t2 = (LAS float*)(lds + AL_T);
    float cbias = 0.f;
    if (KIND == 0) {
        for (int i = tid; i < 640; i += 512) { int rel = i - 63; rel = rel > 256 ? 256 : rel; t2[i] = relb[(rel + 256) * 8 + hd] * LOG2E; }
        cbias = relb[512 * 8 + hd] * LOG2E;
    }
    bf16x8 qf[4];
    { const bf16_t* qp = QKV + (tok0 + qbase + r) * NIN + qcol + h * 8;
#pragma unroll
      for (int ks = 0; ks < 4; ++ks) qf[ks] = *(const bf16x8*)(qp + ks * 16); }
    u32x4 kregA[NLD], vregA[NLD], kregB[NLD], vregB[NLD];
#define ATT_LOAD(kr_, vr_, kc_) do { _Pragma("unroll") for (int i_ = 0; i_ < NLD; ++i_) { const int idx_ = tid + 512 * i_, row_ = idx_ / CPR, ch_ = idx_ % CPR; \
        const bf16_t* s_ = QKV + (tok0 + (size_t)(kc_) * 64 + row_) * NIN + ch_ * 8; kr_[i_] = *(const u32x4*)(s_ + kcol); vr_[i_] = *(const u32x4*)(s_ + vcol); } } while (0)
#define ATT_STORE(kr_, vr_, kb_, vb_) do { _Pragma("unroll") for (int i_ = 0; i_ < NLD; ++i_) { const int idx_ = tid + 512 * i_, row_ = idx_ / CPR, ch_ = idx_ % CPR; \
        *(LAS u32x4*)(lds + AL_K + (kb_) * 64 * KP + row_ * KP + ch_ * 16) = kr_[i_]; *(LAS u32x4*)(lds + AL_V + (vb_) * 64 * VP + row_ * VP + ch_ * 16) = vr_[i_]; } } while (0)
    ATT_LOAD(kregA, vregA, tlo); ATT_STORE(kregA, vregA, 0, 0);
    ATT_LOAD(kregB, vregB, tlo + 1);
    __syncthreads();
    f32x16 O[DVB]; bf16x8 pk[4];
#pragma unroll
    for (int d = 0; d < DVB; ++d)
#pragma unroll
        for (int i = 0; i < 16; ++i) O[d][i] = 0.f;
#pragma unroll
    for (int f = 0; f < 4; ++f) pk[f] = (bf16x8){0, 0, 0, 0, 0, 0, 0, 0};
    float mrun = 0.f, lrun = 0.f;
    int vprev = 2, vcur = 0, vnext = 1;
#define ATT_STEP(kc_, LDK_, LDV_, STK_, STV_) do { const int kc = (kc_); const int kb = (kc - tlo) & 1; \
        if (kc + 2 <= thi) ATT_LOAD(LDK_, LDV_, kc + 2); \
        const bool a1 = (kc >= klo && kc <= qc), a0 = (kc - 1 >= klo && kc - 1 <= qc); \
        const LAS unsigned char* Kl = lds + AL_K + kb * 64 * KP + (KIND == 1 ? comp * 128 : 0); \
        int biasmode = 0; const LAS float* tb = t2; \
        if (KIND == 0) { biasmode = (kc <= qc - 5) ? 2 : 1; tb = t2 + (qbase - kc * 64 + 63) + r - 4 * h; } \
        if (skew && a0) pv_tile<DVB, VP>(lds + AL_V + vprev * 64 * VP, pk, O, lane); \
        if (a1) qk_softmax<DVB, KP>(Kl, qf, O, mrun, lrun, pk, kc == klo, lane, biasmode, tb, cbias); \
        if (!skew && a1) pv_tile<DVB, VP>(lds + AL_V + vcur * 64 * VP, pk, O, lane); \
        if (kc < thi) ATT_STORE(STK_, STV_, kb ^ 1, vnext); \
        __syncthreads(); \
        { const int t_ = vprev; vprev = vcur; vcur = vnext; vnext = t_; } } while (0)
    for (int kc2 = tlo; kc2 <= thi; kc2 += 2) {
        ATT_STEP(kc2, kregA, vregA, kregB, vregB);
        ATT_STEP(kc2 + 1, kregB, vregB, kregA, vregA);
    }
#undef ATT_STEP
#undef ATT_LOAD
#undef ATT_STORE
    if (skew && thi >= klo && thi <= qc) pv_tile<DVB, VP>(lds + AL_V + vprev * 64 * VP, pk, O, lane);
    __syncthreads();
    const float lt = sum_x32(lrun), inv = 1.0f / lt;
    bf16_t* op = OUT + (tok0 + qbase + r) * DM + ocol + 4 * h;
    if (KIND == 0) {
#pragma unroll
        for (int d = 0; d < DVB; ++d)
#pragma unroll
            for (int g4 = 0; g4 < 4; ++g4) { u32x2 w; w.x = cvtpk(O[d][4 * g4] * inv, O[d][4 * g4 + 1] * inv); w.y = cvtpk(O[d][4 * g4 + 2] * inv, O[d][4 * g4 + 3] * inv);
                *(u32x2*)(op + 32 * d + 8 * g4) = w; }
    } else {
        LAS float* X = (LAS float*)(lds + AL_X) + rg * 4096 + lane;
        if (comp == 1) { const float sc = lam * inv;
#pragma unroll
            for (int d = 0; d < DVB; ++d)
#pragma unroll
                for (int i = 0; i < 16; ++i) X[(d * 16 + i) * 64] = O[d][i] * sc; }
        __syncthreads();
        if (comp == 0) {
            float sq = 0.f;
#pragma unroll
            for (int d = 0; d < DVB; ++d)
#pragma unroll
                for (int i = 0; i < 16; ++i) { const float o = O[d][i] * inv - X[(d * 16 + i) * 64]; O[d][i] = o; sq += o * o; }
            sq = sum_x32(sq);
            const float rn = rsqrtf(sq * (1.0f / 128.0f) + EPS) * 0.8f;
#pragma unroll
            for (int d = 0; d < DVB; ++d)
#pragma unroll
                for (int g4 = 0; g4 < 4; ++g4) { const f32x4 gs = *(const f32x4*)(gsub + 32 * d + 8 * g4 + 4 * h);
                    u32x2 w; w.x = cvtpk(O[d][4 * g4] * rn * gs[0], O[d][4 * g4 + 1] * rn * gs[1]); w.y = cvtpk(O[d][4 * g4 + 2] * rn * gs[2], O[d][4 * g4 + 3] * rn * gs[3]);
                    *(u32x2*)(op + 32 * d + 8 * g4) = w; }
        }
        __syncthreads();
    }
}
}

#define XB_TMO      128
#define XB_XCNT(j)  (256  + 64 * (j))
#define XB_XSUB(j)  (1280 + 64 * (j))
#define XB_XGEN(j)  (2304 + 64 * (j))
#define XB_TOP      3328
#define XB_TOPGEN   3392
#define XCD_BAR_WORDS 3456
#define XB_SPIN_CAP (1u << 18)
__device__ __forceinline__ unsigned xb_ld(unsigned* p)              { return __hip_atomic_load(p, __ATOMIC_RELAXED, __HIP_MEMORY_SCOPE_AGENT); }
__device__ __forceinline__ unsigned xb_add(unsigned* p, unsigned v) { return __hip_atomic_fetch_add(p, v, __ATOMIC_RELAXED, __HIP_MEMORY_SCOPE_AGENT); }
__device__ __forceinline__ unsigned xb_xcc_id() { return (unsigned)__builtin_amdgcn_s_getreg((3 << 11) | 20) & 0xFu; }
#define XB_SPIN(cond, bar) do { unsigned _sp = 0; while (cond) { __builtin_amdgcn_s_sleep(1); \
    if ((++_sp & 255u) == 0u) { if (xb_ld(&(bar)[XB_TMO])) break; if (_sp > XB_SPIN_CAP) { atomicAdd(&(bar)[XB_TMO], 1u); break; } } } } while (0)
struct XcdBarrier { unsigned* bar; unsigned x; volatile LAS unsigned* st; };
__device__ __forceinline__ XcdBarrier xcd_barrier_post(unsigned* bar, volatile LAS unsigned* st) {
    XcdBarrier b; b.bar = bar; b.x = xb_xcc_id(); b.st = st;
    if (threadIdx.x == 0) (void)xb_add(&bar[XB_XCNT(b.x)], 1u);
    return b;
}
__device__ __forceinline__ void xcd_barrier_complete(unsigned* bar, unsigned x, unsigned& nloc, unsigned& nx) {
    const unsigned G = gridDim.x * gridDim.y * gridDim.z;
    unsigned sum, cnt, mine, sp = 0u;
    for (;;) {
        sum = 0u; cnt = 0u; mine = 0u;
#pragma unroll
        for (unsigned j = 0; j < 16; ++j) { const unsigned c = xb_ld(&bar[XB_XCNT(j)]); sum += c; cnt += (c > 0u) ? 1u : 0u; mine = (j == x) ? c : mine; }
        if (sum == G) break;
        __builtin_amdgcn_s_sleep(1);
        if ((++sp & 255u) == 0u) { if (xb_ld(&bar[XB_TMO])) break; if (sp > XB_SPIN_CAP) { atomicAdd(&bar[XB_TMO], 1u); break; } }
    }
    nloc = mine > 0u ? mine : 1u; nx = cnt > 0u ? cnt : 1u;
}
__device__ __forceinline__ void xcd_barrier(const XcdBarrier& b) {
    asm volatile("s_waitcnt vmcnt(0)" ::: "memory");
    __syncthreads();
    if (threadIdx.x == 0) {
        unsigned* bar = b.bar;
        __builtin_amdgcn_s_waitcnt(0);
        unsigned nloc = b.st[0], nx = b.st[1];
        if (nloc == 0u) { xcd_barrier_complete(bar, b.x, nloc, nx); b.st[0] = nloc; b.st[1] = nx; }
        const unsigned old = xb_add(&bar[XB_XSUB(b.x)], 1u);
        const unsigned gen = old / nloc;
        if (old + 1u == (gen + 1u) * nloc) {
            __builtin_amdgcn_fence(__ATOMIC_RELEASE, "agent");
            asm volatile("s_waitcnt vmcnt(0)" ::: "memory");
            const unsigned og = xb_add(&bar[XB_TOP], 1u);
            const unsigned tg = og / nx;
            if (og + 1u == (tg + 1u) * nx) xb_add(&bar[XB_TOPGEN], 1u);
            else XB_SPIN(xb_ld(&bar[XB_TOPGEN]) == tg, bar);
            __builtin_amdgcn_fence(__ATOMIC_ACQUIRE, "agent");
            xb_add(&bar[XB_XGEN(b.x)], 1u);
            asm volatile("s_waitcnt vmcnt(0)" ::: "memory");
        } else {
            XB_SPIN(xb_ld(&bar[XB_XGEN(b.x)]) == gen, bar);
            __builtin_amdgcn_fence(__ATOMIC_ACQUIRE, "agent");
            asm volatile("s_waitcnt vmcnt(0)" ::: "memory");
        }
    }
    __syncthreads();
}

constexpr int NWAVES = 8;
constexpr int LDS_BYTES = 147456;
constexpr int LDS_BARST = 147440;
constexpr int N_PHASES = 10;
constexpr size_t OFF_QKV = 0;
constexpr size_t OFF_XB = 335544320;
constexpr size_t OFF_Y = OFF_XB + 67108864;
constexpr size_t OFF_WGU1 = OFF_Y + 67108864;
constexpr size_t OFF_WD1 = OFF_WGU1 + 11534336;
constexpr size_t OFF_WIN = OFF_WD1 + 5767168;
constexpr size_t OFF_WUP = OFF_WIN + 10485760;
constexpr size_t OFF_WOUT = OFF_WUP + 2097152;
constexpr size_t OFF_WGU2 = OFF_WOUT + 2097152;
constexpr size_t OFF_WD2 = OFF_WGU2 + 11534336;
constexpr size_t OFF_SS = OFF_WD2 + 5767168;
constexpr size_t SS_SET = (size_t)16 * M * 4;
constexpr size_t OFF_ROPE = OFF_SS + 4 * SS_SET;
constexpr size_t OFF_BAR = OFF_ROPE + 262144;
constexpr size_t BAR_BYTES = 16384;
constexpr size_t WS_END = OFF_BAR + BAR_BYTES;

struct Args { const float* in[23]; float* out; unsigned char* ws; int ph_lo, ph_hi; };

__device__ __forceinline__ void tr_item(const float* __restrict__ W, int ldw, int k0, int sc0, const float* __restrict__ g, bf16_t* WT, int ldo, int orow0, int kout0, LAS float* scr, int lane) {
    const int kr = lane >> 3, c4 = lane & 7;
    f32x4 v[8];
#pragma unroll
    for (int i = 0; i < 8; ++i) v[i] = *(const f32x4*)(W + (size_t)(k0 + 8 * i + kr) * ldw + sc0 + 4 * c4);
    if (g) {
#pragma unroll
        for (int i = 0; i < 8; ++i) v[i] = v[i] * g[k0 + 8 * i + kr];
    }
#pragma unroll
    for (int i = 0; i < 8; ++i) { LAS float* d = scr + (8 * i + kr) * 33 + 4 * c4; d[0] = v[i][0]; d[1] = v[i][1]; d[2] = v[i][2]; d[3] = v[i][3]; }
    asm volatile("s_waitcnt lgkmcnt(0)" ::: "memory");
    const int c = lane & 7;
#pragma unroll
    for (int j = 0; j < 4; ++j) { const int n = (lane >> 3) + 8 * j; const LAS float* s = scr + (8 * c) * 33 + n;
        u32x4 o; o.x = cvtpk(s[0 * 33], s[1 * 33]); o.y = cvtpk(s[2 * 33], s[3 * 33]); o.z = cvtpk(s[4 * 33], s[5 * 33]); o.w = cvtpk(s[6 * 33], s[7 * 33]);
        *(u32x4*)(WT + (size_t)(orow0 + n) * ldo + kout0 + k0 + 8 * c) = o; }
    asm volatile("s_waitcnt lgkmcnt(0)" ::: "memory");
}
__device__ __forceinline__ void item_gu(const float* W, const float* g, bf16_t* WT, int it, LAS float* scr, int lane) {
    const int kb = it / 176, nb = it % 176, pn = nb >> 3, wb = nb & 7, bj = wb >> 2, j4 = wb & 3;
    tr_item(W, 2 * FF, kb * 64, bj * FF + pn * 128 + j4 * 32, g, WT, DM, nb * 32, 0, scr, lane);
}
__device__ __forceinline__ void item_win(const float* W, const float* g, bf16_t* WT, int it, LAS float* scr, int lane) {
    const int kb = it / 160, nb = it % 160, pn = nb >> 3, wb = nb & 7, bj = wb >> 2, wc = wb & 3;
    const int sc0 = pn < 12 ? pn * 256 + wc * 64 + bj * 32 : 3072 + bj * 1024 + (pn - 12) * 128 + wc * 32;
    tr_item(W, NIN, kb * 64, sc0, g, WT, DM, nb * 32, 0, scr, lane);
}
__device__ __forceinline__ void item_plain(const float* W, int ldw, int nblk, bf16_t* WT, int ldo, int kout0, int it, LAS float* scr, int lane) {
    const int kb = it / nblk, nb = it % nblk;
    tr_item(W, ldw, kb * 64, nb * 32, nullptr, WT, ldo, nb * 32, kout0, scr, lane);
}

__global__ void __launch_bounds__(NWAVES * 64, 2) fwd_kernel(Args args) {
    extern __shared__ __attribute__((aligned(16))) unsigned char lds_raw[];
    LAS unsigned char* lds = (LAS unsigned char*)lds_raw;
    const int tid = threadIdx.x, lane = tid & 63, wave = __builtin_amdgcn_readfirstlane(tid >> 6);
    const int G = gridDim.x, gw = blockIdx.x * NWAVES + wave, NGW = G * NWAVES;
    unsigned char* ws = args.ws;
    const float* x = args.in[0]; const float* g_ffn1 = args.in[1]; const float* w_gu1 = args.in[2]; const float* w_d1 = args.in[3]; const float* g_mix = args.in[4];
    const float* w_in = args.in[5]; const float* qn_a = args.in[6]; const float* kn_a = args.in[7]; const float* rel_bias = args.in[8]; const float* qn_b = args.in[9];
    const float* kn_b = args.in[10]; const float* lq1 = args.in[11]; const float* lk1 = args.in[12]; const float* lq2 = args.in[13]; const float* lk2 = args.in[14];
    const float* g_sub = args.in[15]; const float* w_up_a = args.in[16]; const float* w_up_b = args.in[17]; const float* w_out = args.in[18]; const float* g_ffn2 = args.in[19];
    const float* w_gu2 = args.in[20]; const float* w_d2 = args.in[21]; const float* g_final = args.in[22];
    float* out = args.out;
    bf16_t* QKV = (bf16_t*)(ws + OFF_QKV); bf16_t* Hb = (bf16_t*)(ws + OFF_QKV); bf16_t* XB = (bf16_t*)(ws + OFF_XB); bf16_t* Yb = (bf16_t*)(ws + OFF_Y);
    bf16_t* WGU1 = (bf16_t*)(ws + OFF_WGU1); bf16_t* WD1 = (bf16_t*)(ws + OFF_WD1); bf16_t* WIN = (bf16_t*)(ws + OFF_WIN); bf16_t* WUP = (bf16_t*)(ws + OFF_WUP);
    bf16_t* WOUT = (bf16_t*)(ws + OFF_WOUT); bf16_t* OAB = (bf16_t*)out;
    bf16_t* WGU2 = (bf16_t*)(ws + OFF_WGU2); bf16_t* WD2 = (bf16_t*)(ws + OFF_WD2);
    float* SS0 = (float*)(ws + OFF_SS); float* SS1 = (float*)(ws + OFF_SS + SS_SET); float* SS2 = (float*)(ws + OFF_SS + 2 * SS_SET); float* SS3 = (float*)(ws + OFF_SS + 3 * SS_SET);
    float* ROPE = (float*)(ws + OFF_ROPE);
    const int lo = args.ph_lo, hi = args.ph_hi;
#define IN(k) (lo <= (k) && (k) < hi)
#define SEAM(k) do { if (IN(k) && IN((k) + 1)) { xcd_barrier(gbar); } } while (0)
    if (tid < 2) ((volatile LAS unsigned*)(lds + LDS_BARST))[tid] = 0u;
    __syncthreads();
    XcdBarrier gbar; gbar.bar = (unsigned*)(ws + OFF_BAR); gbar.x = 0; gbar.st = nullptr;
    if (hi - lo > 1) gbar = xcd_barrier_post((unsigned*)(ws + OFF_BAR), (volatile LAS unsigned*)(lds + LDS_BARST));
    if (lo < 0) cg::this_grid().sync();

    if (IN(0)) {
        LAS float* scr = (LAS float*)(lds + wave * 16384);
        constexpr int I_GU = 16 * 176, I_DN = 44 * 32, I_WIN = 16 * 160, I_UP = 8 * 32, I_OUT = 16 * 32;
        constexpr int NITEMS = 2 * I_GU + 2 * I_DN + I_WIN + 2 * I_UP + I_OUT;
        for (int it = gw; it < NITEMS; it += NGW) {
            int r = it;
            if (r < I_GU) { item_gu(w_gu1, g_ffn1, WGU1, r, scr, lane); continue; } r -= I_GU;
            if (r < I_GU) { item_gu(w_gu2, g_ffn2, WGU2, r, scr, lane); continue; } r -= I_GU;
            if (r < I_WIN) { item_win(w_in, g_mix, WIN, r, scr, lane); continue; } r -= I_WIN;
            if (r < I_DN) { item_plain(w_d1, DM, 32, WD1, FF, 0, r, scr, lane); continue; } r -= I_DN;
            if (r < I_DN) { item_plain(w_d2, DM, 32, WD2, FF, 0, r, scr, lane); continue; } r -= I_DN;
            if (r < I_UP) { item_plain(w_up_a, DM, 32, WUP, DM, 0, r, scr, lane); continue; } r -= I_UP;
            if (r < I_UP) { item_plain(w_up_b, DM, 32, WUP, DM, 512, r, scr, lane); continue; } r -= I_UP;
            item_plain(w_out, DM, 32, WOUT, DM, 0, r, scr, lane);
        }
        for (int m0 = gw * 4; m0 < M; m0 += NGW * 4) {
            f32x4 v[4][4];
#pragma unroll
            for (int q = 0; q < 4; ++q) { const f32x4* xr = (const f32x4*)(x + (size_t)(m0 + q) * DM) + lane;
#pragma unroll
                for (int j = 0; j < 4; ++j) v[q][j] = xr[64 * j]; }
#pragma unroll
            for (int q = 0; q < 4; ++q) { float s = 0.f;
#pragma unroll
                for (int j = 0; j < 4; ++j) s += (v[q][j][0] * v[q][j][0] + v[q][j][1] * v[q][j][1]) + (v[q][j][2] * v[q][j][2] + v[q][j][3] * v[q][j][3]);
                s = wave_sum(s);
                if (lane == 0) SS0[m0 + q] = s;
                u32x2* o8 = (u32x2*)(XB + (size_t)(m0 + q) * DM) + lane;
#pragma unroll
                for (int j = 0; j < 4; ++j) { u32x2 w; w.x = cvtpk(v[q][j][0], v[q][j][1]); w.y = cvtpk(v[q][j][2], v[q][j][3]); o8[64 * j] = w; } }
        }
        for (int e = blockIdx.x * 512 + tid; e < SEQ * 8; e += G * 512) {
            const int pos = e >> 3, dd = e & 7;
            const float inv = exp2f(-(float)dd * 0.125f * 18.931568569324174f);
            const float ang = (float)pos * inv;
            const double rev = (double)ang * 0.15915494309189535;
            const float fr = (float)(rev - floor(rev));
            ROPE[e * 2] = __builtin_amdgcn_cosf(fr); ROPE[e * 2 + 1] = __builtin_amdgcn_sinf(fr);
        }
    }
    SEAM(0);
    if (IN(1)) {
        pg8::Gemm g{XB, WGU1, DM, DM, DM, 0, 0}; pg8::StaticOrder S; S.init(M, 2 * FF, G, (int)blockIdx.x, 1);
        pg8::EpiSwiglu<1> E{Hb, SS0};
        pg8::gemm_phase(lds, g, S, E);
    }
    SEAM(1);
    if (IN(2)) {
        pg8::Gemm g{Hb, WD1, FF, FF, FF, 0, 0}; pg8::StaticOrder S; S.init(M, DM, G, (int)blockIdx.x, 1);
        pg8::EpiResid<false> E{x, XB, SS1, 0.5f};
        pg8::gemm_phase(lds, g, S, E);
    }
    SEAM(2);
    if (IN(3)) {
        pg8::Gemm g{XB, WIN, DM, DM, DM, 0, 0}; pg8::StaticOrder S; S.init(M, NIN, G, (int)blockIdx.x, 1);
        pg8::EpiWin<16> E{QKV, SS1, qn_a, kn_a, qn_b, kn_b, ROPE};
        pg8::gemm_phase(lds, g, S, E);
    }
    SEAM(3);
    if (IN(4)) {
        const float s1 = wave_sum(lq1[lane] * lk1[lane]), s2 = wave_sum(lq2[lane] * lk2[lane]);
        const float lam = expf(s1) - expf(s2) + 0.2f;
        const int vcu = (G % 8 == 0) ? ((int)blockIdx.x % 8) * (G / 8) + (int)blockIdx.x / 8 : (int)blockIdx.x;
        for (int u = vcu; u < 1024; u += G) {
            const int grp = u & 15, hd = (u >> 4) & 7, b = u >> 7;
            att::attn_unit<0>(lds, QKV, OAB, b, hd, grp, rel_bias, 0.f, nullptr);
        }
        __syncthreads();
        for (int p = vcu; p < 512; p += G) {
            const int jj = p & 15, bh = p >> 4, hd = bh & 3, b = bh >> 2;
            att::attn_unit<1>(lds, QKV, OAB, b, hd, jj, nullptr, lam, g_sub);
            att::attn_unit<1>(lds, QKV, OAB, b, hd, 31 - jj, nullptr, lam, g_sub);
        }
    }
    SEAM(4);
    if (IN(5)) {
        pg8::Gemm g{OAB, WUP, DM, DM, 512, 512, 512}; pg8::StaticOrder S; S.init(M, DM, G, (int)blockIdx.x, 2);
        pg8::EpiUp E{QKV, Yb};
        pg8::gemm_phase(lds, g, S, E);
    }
    SEAM(5);
    if (IN(6)) {
        pg8::Gemm g{Yb, WOUT, DM, DM, DM, 0, 0}; pg8::StaticOrder S; S.init(M, DM, G, (int)blockIdx.x, 1);
        pg8::EpiResid<true> E{XB, XB, SS2, 1.0f};
        pg8::gemm_phase(lds, g, S, E);
    }
    SEAM(6);
    if (IN(7)) {
        pg8::Gemm g{XB, WGU2, DM, DM, DM, 0, 0}; pg8::StaticOrder S; S.init(M, 2 * FF, G, (int)blockIdx.x, 1);
        pg8::EpiSwiglu<16> E{Hb, SS2};
        pg8::gemm_phase(lds, g, S, E);
    }
    SEAM(7);
    if (IN(8)) {
        pg8::Gemm g{Hb, WD2, FF, FF, FF, 0, 0}; pg8::StaticOrder S; S.init(M, DM, G, (int)blockIdx.x, 1);
        pg8::EpiResid<true> E{XB, XB, SS3, 0.5f};
        pg8::gemm_phase(lds, g, S, E);
    }
    SEAM(8);
    if (IN(9)) {
        const f32x4* gr = (const f32x4*)g_final + lane;
        f32x4 gg[4];
#pragma unroll
        for (int j = 0; j < 4; ++j) gg[j] = gr[64 * j];
        for (int m0 = gw * 4; m0 < M; m0 += NGW * 4) {
            float sp[4]; u32x2 w[4][4];
#pragma unroll
            for (int q = 0; q < 4; ++q) { sp[q] = SS3[(size_t)(lane & 15) * M + m0 + q]; const u32x2* xr = (const u32x2*)(XB + (size_t)(m0 + q) * DM) + lane;
#pragma unroll
                for (int j = 0; j < 4; ++j) w[q][j] = xr[64 * j]; }
#pragma unroll
            for (int q = 0; q < 4; ++q) { float sv = sp[q];
                sv += __shfl_xor(sv, 1); sv += __shfl_xor(sv, 2); sv += __shfl_xor(sv, 4); sv += __shfl_xor(sv, 8);
                const float rs = rsqrtf(sv * (1.0f / DM) + EPS);
                f32x4* orow = (f32x4*)(out + (size_t)(m0 + q) * DM) + lane;
#pragma unroll
                for (int j = 0; j < 4; ++j) { f32x4 o; o[0] = bflo(w[q][j].x) * rs * gg[j][0]; o[1] = bfhi(w[q][j].x) * rs * gg[j][1]; o[2] = bflo(w[q][j].y) * rs * gg[j][2]; o[3] = bfhi(w[q][j].y) * rs * gg[j][3]; orow[64 * j] = o; } }
        }
    }
#undef IN
#undef SEAM
}

extern "C" void kernel_launch(void* const* d_in, const int* in_sizes, int n_in, void* d_out, int out_size, void* d_ws, size_t ws_size, hipStream_t stream) {
    static int grid = 0;
    if (grid == 0) {
        if (n_in != 23 || in_sizes[0] != M * DM || out_size != M * DM || ws_size < WS_END) {
            fprintf(stderr, "kernel_launch: unexpected shapes (n_in %d, in0 %d, out %d, ws %zu need %zu)\n", n_in, n_in > 0 ? in_sizes[0] : -1, out_size, ws_size, (size_t)WS_END); grid = -1; return; }
        int dev = 0, cus = 0, per_cu = 0;
        hipGetDevice(&dev); hipDeviceGetAttribute(&cus, hipDeviceAttributeMultiprocessorCount, dev);
        hipFuncSetAttribute((const void*)fwd_kernel, hipFuncAttributeMaxDynamicSharedMemorySize, LDS_BYTES);
        hipOccupancyMaxActiveBlocksPerMultiprocessor(&per_cu, (const void*)fwd_kernel, NWAVES * 64, LDS_BYTES);
        if (per_cu < 1) { fprintf(stderr, "kernel_launch: occupancy query says %d blocks/CU\n", per_cu); per_cu = 1; }
        (void)hipGetLastError();
        grid = cus * per_cu;
    }
    if (grid < 0) return;
    Args a{};
    for (int i = 0; i < 23; ++i) a.in[i] = (const float*)d_in[i];
    a.out = (float*)d_out; a.ws = (unsigned char*)d_ws;
    if (MK_N_LAUNCHES == 1) {
        hipMemsetAsync((unsigned char*)d_ws + OFF_BAR, 0, BAR_BYTES, stream);
        a.ph_lo = 0; a.ph_hi = N_PHASES;
        void* kargs[] = {&a};
        hipError_t e = hipLaunchCooperativeKernel((const void*)fwd_kernel, dim3(grid), dim3(NWAVES * 64), kargs, LDS_BYTES, stream);
        if (e != hipSuccess) fprintf(stderr, "cooperative launch failed: %s (grid %d)\n", hipGetErrorString(e), grid);
    } else {
        for (int p = 0; p < N_PHASES; ++p) { a.ph_lo = p; a.ph_hi = p + 1; for (int rep = 0; rep < (p == PROBE_REP_PHASE ? 2 : 1); ++rep) hipLaunchKernelGGL(fwd_kernel, dim3(grid), dim3(NWAVES * 64), LDS_BYTES, stream, a); }
    }
}
```
